# Optimizing an MI355X kernel written in HIP

```python
import jax, jax.numpy as jnp
from jax import lax
import numpy as np

D_MODEL = 1024
BATCH = 4
SEQ = 8192
DEPTH = 2

N_META = 16
BLOCK_Q = 128
N_HEADS_SB = 8
N_HEADS_FOX = 8
HEAD_DIM = D_MODEL // (N_HEADS_SB + N_HEADS_FOX)
D_SB = N_HEADS_SB * HEAD_DIM
D_FOX = N_HEADS_FOX * HEAD_DIM
D_IN_ATTN = 3 * D_SB + 3 * D_FOX + N_HEADS_FOX
D_FF = 2816
POOL_WINDOWS = (2, 4, 8, 16)
N_POOL_GROUPS = len(POOL_WINDOWS)
POOL_GROUP = D_MODEL // N_POOL_GROUPS
RMS_EPS = 1e-6
N_EVEN = (DEPTH + 1) // 2
N_ODD = DEPTH // 2

kernel_name = "hybrid_stickbreak_fox_pool_macaron"


def rms_norm(x, g):
    xf = x.astype(jnp.float32)
    y = xf * lax.rsqrt(jnp.mean(xf * xf, axis=-1, keepdims=True) + RMS_EPS)
    return (y * g.astype(jnp.float32)).astype(x.dtype)


def swiglu(h, w_in, w_out):
    u = h @ w_in
    gate, up = u[..., :D_FF], u[..., D_FF:]
    return (jax.nn.silu(gate) * up) @ w_out


def attn_mixer(h, w_in, b_f, w_out):
    B, L, _ = h.shape
    proj = h @ w_in
    offs = np.cumsum([0, D_SB, D_SB, D_SB, D_FOX, D_FOX, D_FOX])

    def heads(i, n):
        t = proj[..., offs[i]:offs[i + 1]]
        return t.reshape(B, L, n, HEAD_DIM).transpose(0, 2, 1, 3)

    qa, ka, va = heads(0, N_HEADS_SB), heads(1, N_HEADS_SB), heads(2, N_HEADS_SB)
    qb, kb, vb = heads(3, N_HEADS_FOX), heads(4, N_HEADS_FOX), heads(5, N_HEADS_FOX)
    f_logit = proj[..., offs[6]:]
    log_f = jax.nn.log_sigmoid(f_logit.astype(jnp.float32) + b_f.astype(jnp.float32))
    c = jnp.cumsum(log_f, axis=1).transpose(0, 2, 1)

    scale = HEAD_DIM ** -0.5
    starts = [0] + list(range(N_META, L, BLOCK_Q))
    ends = starts[1:] + [L]
    out_sb, out_fox = [], []
    for q0, q1 in zip(starts, ends):
        tpos = jnp.arange(q0, q1)[:, None]
        spos = jnp.arange(q1)[None, :]
        strict = spos < tpos
        causal = spos <= tpos

        z = jnp.einsum('bhqd,bhkd->bhqk', qa[:, :, q0:q1], ka[:, :, :q1]).astype(jnp.float32) * scale
        log_not = jnp.where(strict, jax.nn.log_sigmoid(-z), 0.0)
        rest = lax.cumsum(log_not, axis=3, reverse=True) - log_not
        a_w = jnp.where(strict, jnp.exp(jax.nn.log_sigmoid(z) + rest), 0.0)
        out_sb.append(jnp.einsum('bhqk,bhkd->bhqd', a_w.astype(va.dtype), va[:, :, :q1]))

        s = jnp.einsum('bhqd,bhkd->bhqk', qb[:, :, q0:q1], kb[:, :, :q1]).astype(jnp.float32) * scale
        s = s + c[:, :, q0:q1, None] - c[:, :, None, :q1]
        p = jax.nn.softmax(jnp.where(causal, s, -jnp.inf), axis=-1)
        out_fox.append(jnp.einsum('bhqk,bhkd->bhqd', p.astype(vb.dtype), vb[:, :, :q1]))

    o_sb = jnp.concatenate(out_sb, axis=2).transpose(0, 2, 1, 3).reshape(B, L, D_SB)
    o_fox = jnp.concatenate(out_fox, axis=2).transpose(0, 2, 1, 3).reshape(B, L, D_FOX)
    return jnp.concatenate([o_sb, o_fox], axis=-1) @ w_out


def pool_mixer(h, w_pool, scale):
    B, L, _ = h.shape
    hf = h.astype(jnp.float32).reshape(B, L, N_POOL_GROUPS, POOL_GROUP)
    cs0 = jnp.concatenate([jnp.zeros((B, 1, N_POOL_GROUPS, POOL_GROUP), jnp.float32),
                           jnp.cumsum(hf, axis=1)], axis=1)
    t = jnp.arange(L)
    pooled = []
    for g, w in enumerate(POOL_WINDOWS):
        cg = cs0[:, :, g]
        upper = cg[:, 1:]
        lower = jnp.concatenate([jnp.zeros((B, w - 1, POOL_GROUP), jnp.float32),
                                 cg[:, :L - w + 1]], axis=1)
        cnt = jnp.minimum(t + 1, w).astype(jnp.float32)[None, :, None]
        pooled.append((upper - lower) / cnt - hf[:, :, g])
    p = jnp.stack(pooled, axis=2).astype(h.dtype)
    y = jnp.einsum('blgc,gcd->blgd', p, w_pool).reshape(B, L, D_MODEL)
    return y * scale


def setup_inputs(seed: int = 0) -> dict:
    key = jax.random.key(seed)
    ks = jax.random.split(key, 20)
    f32 = jnp.float32
    nrm = lambda k, shp, s: jax.random.normal(k, shp, f32) * s
    return {
        "x": nrm(ks[0], (BATCH, SEQ, D_MODEL), 1.0),
        "meta_tokens": nrm(ks[1], (N_META, D_MODEL), 1.0),
        "g_ffn1": 1.0 + nrm(ks[2], (DEPTH, D_MODEL), 0.02),
        "w_ffn1_in": nrm(ks[3], (DEPTH, D_MODEL, 2 * D_FF), D_MODEL ** -0.5),
        "w_ffn1_out": nrm(ks[4], (DEPTH, D_FF, D_MODEL), D_FF ** -0.5),
        "g_mix": 1.0 + nrm(ks[5], (DEPTH, D_MODEL), 0.02),
        "g_ffn2": 1.0 + nrm(ks[6], (DEPTH, D_MODEL), 0.02),
        "w_ffn2_in": nrm(ks[7], (DEPTH, D_MODEL, 2 * D_FF), D_MODEL ** -0.5),
        "w_ffn2_out": nrm(ks[8], (DEPTH, D_FF, D_MODEL), D_FF ** -0.5),
        "w_attn_in": nrm(ks[9], (N_EVEN, D_MODEL, D_IN_ATTN), D_MODEL ** -0.5),
        "b_forget": 2.0 + nrm(ks[10], (N_EVEN, N_HEADS_FOX), 0.1),
        "w_attn_out": nrm(ks[11], (N_EVEN, D_SB + D_FOX, D_MODEL), (D_SB + D_FOX) ** -0.5),
        "w_pool": nrm(ks[12], (N_ODD, N_POOL_GROUPS, POOL_GROUP, POOL_GROUP), POOL_GROUP ** -0.5),
        "pool_scale": 1.0 + nrm(ks[13], (N_ODD, D_MODEL), 0.02),
        "g_final": 1.0 + nrm(ks[14], (D_MODEL,), 0.02),
    }


def reference(x, meta_tokens, g_ffn1, w_ffn1_in, w_ffn1_out, g_mix, g_ffn2,
              w_ffn2_in, w_ffn2_out, w_attn_in, b_forget, w_attn_out,
              w_pool, pool_scale, g_final):
    B = x.shape[0]
    meta = jnp.broadcast_to(meta_tokens[None].astype(x.dtype), (B, N_META, D_MODEL))
    h = jnp.concatenate([meta, x], axis=1)
    for layer in range(DEPTH):
        h = h + 0.5 * swiglu(rms_norm(h, g_ffn1[layer]), w_ffn1_in[layer], w_ffn1_out[layer])
        u = rms_norm(h, g_mix[layer])
        i = layer // 2
        if layer % 2 == 0:
            h = h + attn_mixer(u, w_attn_in[i], b_forget[i], w_attn_out[i])
        else:
            h = h + pool_mixer(u, w_pool[i], pool_scale[i])
        h = h + 0.5 * swiglu(rms_norm(h, g_ffn2[layer]), w_ffn2_in[layer], w_ffn2_out[layer])
    return rms_norm(h, g_final)[:, N_META:]
```

```cpp
#include <hip/hip_runtime.h>
#include <hip/hip_cooperative_groups.h>
#include <cstdio>
#include <cstdint>
namespace cg = cooperative_groups;

#ifndef ONE_LAUNCH
#define ONE_LAUNCH 1
#endif

#define LAS __attribute__((address_space(3)))
typedef unsigned short bf16_t;
typedef short bf16x8 __attribute__((ext_vector_type(8)));
typedef short s16x4 __attribute__((ext_vector_type(4)));
typedef float f32x4 __attribute__((ext_vector_type(4)));
typedef float f32x2 __attribute__((ext_vector_type(2)));
typedef float f32x16 __attribute__((ext_vector_type(16)));
typedef unsigned u32x4 __attribute__((ext_vector_type(4)));
typedef unsigned u32x2 __attribute__((ext_vector_type(2)));

constexpr int DM = 1024, NB = 4, SEQ = 8192, NMETA = 16, DFF = 2816;
constexpr int NREAL = NB * SEQ;
constexpr int MROW = NREAL;
constexpr int MP = 33024;
constexpr int DQKV = 3072, NATT = 3328;
constexpr float EPS = 1e-6f;
constexpr float LOG2E = 1.4426950408889634f;
constexpr float QSCALE = 0.125f * LOG2E;
constexpr float THR2 = -152.0f;

constexpr size_t MiB = 1u << 20;
constexpr size_t WS_CTL = 0;
constexpr size_t WS_WIN = 1 * MiB;
constexpr size_t WIN_BYTES = (size_t)5632 * 1024 * 2;
constexpr size_t WS_WOUT = WS_WIN + 4 * WIN_BYTES;
constexpr size_t WOUT_BYTES = (size_t)1024 * 2816 * 2;
constexpr size_t WS_WAI = WS_WOUT + 4 * WOUT_BYTES;
constexpr size_t WS_WAO = WS_WAI + (size_t)NATT * 1024 * 2;
constexpr size_t WS_WPOOL = WS_WAO + (size_t)1024 * 1024 * 2;
constexpr size_t WS_HB = WS_WPOOL + (size_t)1024 * 256 * 2;
constexpr size_t WS_SSQ = WS_HB + (size_t)MP * 1024 * 2;
constexpr size_t WS_HMETA = WS_SSQ + (size_t)MP * 16 * 4;
constexpr size_t WS_OB = WS_HMETA + (size_t)256 * 1024 * 4;
constexpr size_t WS_LOGF = WS_OB + (size_t)MP * 1024 * 2;
constexpr size_t WS_C2 = WS_LOGF + (size_t)MP * 8 * 4;
constexpr size_t WS_C2M = WS_C2 + (size_t)32 * 8192 * 4;
constexpr size_t WS_SSQM = WS_C2M + 4096;
constexpr size_t WS_BIG = WS_SSQM + 4096;
constexpr size_t WS_END = WS_BIG + (size_t)MP * DQKV * 2;

constexpr int LDS_BYTES = 147456;
constexpr int LDS_MISC = LDS_BYTES - 64;
constexpr size_t CTL_BAR = 16384, CTL_ZERO = 65536;

namespace pg8 {
constexpr int BM = 256, BK = 64, HALF = 128, HTB = HALF * BK * 2, STAGE_BYTES = 8 * HTB, NXCD = 8, WGM = 4;
__host__ __device__ __forceinline__ int lds_byte(int r, int c) { const int st = (r >> 4) * 2 + (c >> 5), rr = r & 15, cc = c & 31, ob = rr * 64 + cc * 2; return st * 1024 + (ob ^ (((ob >> 9) & 1) << 5)); }
__host__ __device__ __forceinline__ void stage_rc(int b, int& R, int& C) { const int st = b / 1024, sb = b % 1024, swz = sb ^ (((sb >> 9) & 1) << 5); R = (st >> 1) * 16 + swz / 64; C = (st & 1) * 32 + (swz % 64) / 2; }
__host__ __device__ __forceinline__ int perm32(int rho) { const int n = rho >> 4, i = rho & 15; return 8 * (i >> 2) + 4 * n + (i & 3); }

struct Unit { int pm, pn; };
struct Gemm { const bf16_t* A; const bf16_t* Bt; int M, N, K, lda, ldb, acol; };

struct StaticOrder {
    int nM, nN, nwg, G, c;
    __device__ void init(int M, int N, int G_, int c_) { nM = M / BM; nN = N / BM; nwg = nM * nN; G = G_; c = c_; }
    __device__ bool next(int i, Unit& u) const {
        const long L = (long)i * G + c; if (L >= nwg) return false;
        int wgid = (int)L; { const int q = nwg / NXCD, r = nwg % NXCD, xcd = wgid % NXCD, off = wgid / NXCD; wgid = (xcd < r ? xcd * (q + 1) : r * (q + 1) + (xcd - r) * q) + off; }
        const int nig = WGM * nN, gid = wgid / nig, fm = gid * WGM, gsz = (nM - fm) < WGM ? (nM - fm) : WGM;
        u.pm = fm + ((wgid % nig) % gsz); u.pn = (wgid % nig) / gsz; return true;
    }
};

typedef __bf16 bf16x2_t __attribute__((ext_vector_type(2)));
__device__ __forceinline__ unsigned cvt_pk_bf16(float lo, float hi) { const f32x2 v = {lo, hi}; const bf16x2_t b = __builtin_convertvector(v, bf16x2_t); return __builtin_bit_cast(unsigned, b); }

__device__ __forceinline__ float row_rstd(const float* ssq, int row) {
    const f32x4* p = (const f32x4*)(ssq + (size_t)row * 16);
    const f32x4 a = p[0], b = p[1], c = p[2], d = p[3];
    const float s = ((a[0] + a[1]) + (a[2] + a[3])) + ((b[0] + b[1]) + (b[2] + b[3])) + ((c[0] + c[1]) + (c[2] + c[3])) + ((d[0] + d[1]) + (d[2] + d[3]));
    return 1.0f / sqrtf(s * (1.0f / 1024.0f) + EPS);
}
__device__ __forceinline__ float fq_sum(float v) {
    auto a = __builtin_amdgcn_permlane16_swap(__float_as_uint(v), __float_as_uint(v), false, false);
    v = __uint_as_float(a[0]) + __uint_as_float(a[1]);
    auto b = __builtin_amdgcn_permlane32_swap(__float_as_uint(v), __float_as_uint(v), false, false);
    return __uint_as_float(b[0]) + __uint_as_float(b[1]);
}
__device__ __forceinline__ float row_rstd4(const float* ssq, int row, int fq) {
    const f32x4 a = *(const f32x4*)(ssq + (size_t)row * 16 + 4 * fq);
    float s = (a[0] + a[1]) + (a[2] + a[3]);
    s = fq_sum(s);
    return __builtin_amdgcn_rsqf(s * (1.0f / 1024.0f) + EPS);
}
__device__ __forceinline__ float silu_mul2(float gp, float upp) { return gp * upp * __builtin_amdgcn_rcpf(1.0f + __builtin_amdgcn_exp2f(-gp)); }
__device__ __forceinline__ float silu_mul(float g, float u) { return g * __builtin_amdgcn_rcpf(1.0f + __builtin_amdgcn_exp2f(-g * LOG2E)) * u; }

struct EpiSwiGLU {
    static constexpr bool PERM = true;
    bf16_t* Hd; const float* ssq;
    static __device__ __forceinline__ float act(float g, float u, float rs) {
        float t = g * rs; asm("" : "+v"(t));
        float uu = u * rs; asm("" : "+v"(uu));
        float d = 1.0f + __builtin_amdgcn_exp2f(-t); asm("" : "+v"(d));
        float tu = t * uu; asm("" : "+v"(tu));
        return tu * __builtin_amdgcn_rcpf(d);
    }
    __device__ __forceinline__ void operator()(const f32x4 (&acc)[2][2][4][2], const Unit& u, int wr, int wc, int fr, int fq) const {
        float rsv[2][4];
#pragma unroll
        for (int ai = 0; ai < 2; ++ai)
#pragma unroll
            for (int m = 0; m < 4; ++m) rsv[ai][m] = row_rstd4(ssq, u.pm * BM + ai * HALF + wr * 64 + m * 16 + fr, fq);
#pragma unroll
        for (int ai = 0; ai < 2; ++ai)
#pragma unroll
            for (int m = 0; m < 4; ++m) {
                const int row = u.pm * BM + ai * HALF + wr * 64 + m * 16 + fr;
                const float rs = rsv[ai][m];
                u32x4 w;
                w.x = cvt_pk_bf16(act(acc[ai][0][m][0][0], acc[ai][1][m][0][0], rs), act(acc[ai][0][m][0][1], acc[ai][1][m][0][1], rs));
                w.y = cvt_pk_bf16(act(acc[ai][0][m][0][2], acc[ai][1][m][0][2], rs), act(acc[ai][0][m][0][3], acc[ai][1][m][0][3], rs));
                w.z = cvt_pk_bf16(act(acc[ai][0][m][1][0], acc[ai][1][m][1][0], rs), act(acc[ai][0][m][1][1], acc[ai][1][m][1][1], rs));
                w.w = cvt_pk_bf16(act(acc[ai][0][m][1][2], acc[ai][1][m][1][2], rs), act(acc[ai][0][m][1][3], acc[ai][1][m][1][3], rs));
                __builtin_nontemporal_store(w, (u32x4*)(Hd + (size_t)row * DFF + u.pn * 128 + wc * 32 + 8 * fq));
            }
    }
};
struct EpiResid {
    static constexpr bool PERM = true;
    float* outf; bf16_t* hb; float* ssq; const float* colscale; float alpha; int last;
    __device__ __forceinline__ void operator()(const f32x4 (&acc)[2][2][4][2], const Unit& u, int wr, int wc, int fr, int fq) const {
        f32x4 sc[2][2];
#pragma unroll
        for (int bj = 0; bj < 2; ++bj)
#pragma unroll
            for (int n = 0; n < 2; ++n) { const int c = u.pn * BM + bj * HALF + wc * 32 + 8 * fq + 4 * n;
                sc[bj][n] = colscale ? *(const f32x4*)(colscale + c) * alpha : (f32x4){alpha, alpha, alpha, alpha}; }
#pragma unroll
        for (int ai = 0; ai < 2; ++ai) {
            u32x4 hpre[4][2];
#pragma unroll
            for (int m = 0; m < 4; ++m)
#pragma unroll
                for (int bj = 0; bj < 2; ++bj) hpre[m][bj] = *(const u32x4*)(hb + (size_t)(u.pm * BM + ai * HALF + wr * 64 + m * 16 + fr) * DM + u.pn * BM + bj * HALF + wc * 32 + 8 * fq);
#pragma unroll
            for (int m = 0; m < 4; ++m) {
                const int row = u.pm * BM + ai * HALF + wr * 64 + m * 16 + fr;
                float s = 0.f;
#pragma unroll
                for (int bj = 0; bj < 2; ++bj) { const int c0 = u.pn * BM + bj * HALF + wc * 32 + 8 * fq;
                    const u32x4 hv = hpre[m][bj];
                    f32x4 h0 = (f32x4){__builtin_bit_cast(float, hv.x << 16), __builtin_bit_cast(float, hv.x & 0xffff0000u), __builtin_bit_cast(float, hv.y << 16), __builtin_bit_cast(float, hv.y & 0xffff0000u)};
                    f32x4 h1 = (f32x4){__builtin_bit_cast(float, hv.z << 16), __builtin_bit_cast(float, hv.z & 0xffff0000u), __builtin_bit_cast(float, hv.w << 16), __builtin_bit_cast(float, hv.w & 0xffff0000u)};
                    h0 = h0 + acc[ai][bj][m][0] * sc[bj][0]; h1 = h1 + acc[ai][bj][m][1] * sc[bj][1];
                    s += ((h0[0] * h0[0] + h0[1] * h0[1]) + (h0[2] * h0[2] + h0[3] * h0[3])) + ((h1[0] * h1[0] + h1[1] * h1[1]) + (h1[2] * h1[2] + h1[3] * h1[3]));
                    if (last) { *(f32x4*)(outf + (size_t)row * DM + c0) = h0; *(f32x4*)(outf + (size_t)row * DM + c0 + 4) = h1; }
                    else { u32x4 w; w.x = cvt_pk_bf16(h0[0], h0[1]); w.y = cvt_pk_bf16(h0[2], h0[3]); w.z = cvt_pk_bf16(h1[0], h1[1]); w.w = cvt_pk_bf16(h1[2], h1[3]); *(u32x4*)(hb + (size_t)row * DM + c0) = w; } }
                s = fq_sum(s);
                if (!last && fq == 0) ssq[(size_t)row * 16 + u.pn * 4 + wc] = s;
            }
        }
    }
};
struct EpiQKV {
    static constexpr bool PERM = true;
    bf16_t* qkv; float* logf; const float* ssq; const float* bf;
    __device__ __forceinline__ void operator()(const f32x4 (&acc)[2][2][4][2], const Unit& u, int wr, int wc, int fr, int fq) const {
        float rsv[2][4];
#pragma unroll
        for (int ai = 0; ai < 2; ++ai)
#pragma unroll
            for (int m = 0; m < 4; ++m) rsv[ai][m] = row_rstd4(ssq, u.pm * BM + ai * HALF + wr * 64 + m * 16 + fr, fq);
#pragma unroll
        for (int ai = 0; ai < 2; ++ai)
#pragma unroll
            for (int m = 0; m < 4; ++m) {
                const int row = u.pm * BM + ai * HALF + wr * 64 + m * 16 + fr;
                const float rs = rsv[ai][m];
                if (u.pn < 12) {
#pragma unroll
                    for (int bj = 0; bj < 2; ++bj) { const int c0 = u.pn * BM + bj * HALF + wc * 32 + 8 * fq;
                        const float s = ((c0 < 512) || (c0 >= 1536 && c0 < 2048)) ? rs * QSCALE : rs;
                        const f32x4 v0 = acc[ai][bj][m][0] * s, v1 = acc[ai][bj][m][1] * s; u32x4 w;
                        w.x = cvt_pk_bf16(v0[0], v0[1]); w.y = cvt_pk_bf16(v0[2], v0[3]); w.z = cvt_pk_bf16(v1[0], v1[1]); w.w = cvt_pk_bf16(v1[2], v1[3]);
                        __builtin_nontemporal_store(w, (u32x4*)(qkv + (size_t)row * DQKV + c0)); }
                } else if (wc == 0 && fq == 0) {
                    f32x4 o[2];
#pragma unroll
                    for (int n = 0; n < 2; ++n) { const f32x4 x = acc[ai][0][m][n] * rs + *(const f32x4*)(bf + 4 * n);
#pragma unroll
                        for (int i = 0; i < 4; ++i) { const float xv = x[i]; o[n][i] = fminf(xv, 0.f) * LOG2E - __builtin_amdgcn_logf(1.0f + __builtin_amdgcn_exp2f(-fabsf(xv) * LOG2E)); } }
                    *(f32x4*)(logf + (size_t)row * 8) = o[0]; *(f32x4*)(logf + (size_t)row * 8 + 4) = o[1];
                }
            }
    }
};

template <class Epi, class Sched>
__device__ __forceinline__ void gemm_phase(LAS unsigned char* lds, const Gemm g, const Sched& S, const Epi& E) {
    const int tid = threadIdx.x, wid = __builtin_amdgcn_readfirstlane(tid >> 6), lane = tid & 63, wr = wid >> 2, wc = wid & 3, fr = lane & 15, fq = lane >> 4;
    const int K = g.K, nt = K / BK;
    unsigned voffA[2], voffB[2];
#pragma unroll
    for (int i = 0; i < 2; ++i) { int R, C; stage_rc(tid * 16 + i * 8192, R, C); const int Rb = Epi::PERM ? ((R & ~31) + perm32(R & 31)) : R;
        voffA[i] = (unsigned)(R * g.lda + C) * 2u; voffB[i] = (unsigned)(Rb * g.ldb + C) * 2u; }
    const size_t kstep = (size_t)(BK * 2);
    const size_t hstepA = (size_t)HALF * g.lda * 2, hstepB = (size_t)HALF * g.ldb * 2;
    const size_t tstepA = 2 * hstepA, tstepB = 2 * hstepB;
    const unsigned ldsw = (unsigned)wid * 1024u;
    const int aoff = lds_byte(wr * 64 + fr, fq * 8), boff = lds_byte(wc * 32 + fr, fq * 8);
#define PG8_SA(b, h) (((b) * 2 + (h)) * HTB)
#define PG8_SB(b, h) ((4 + (b) * 2 + (h)) * HTB)
#define PG8_STAGE(bufoff, gbase, voff) do { _Pragma("unroll") for (int _i = 0; _i < 2; ++_i) \
        __builtin_amdgcn_global_load_lds((const unsigned*)((const char*)(gbase) + (voff)[_i]), (LAS unsigned*)(lds + (bufoff) + ldsw + _i * 8192), 16, 0, 0); } while (0)
#define PG8_LDA(dst, b, h) do { _Pragma("unroll") for (int m = 0; m < 4; ++m) _Pragma("unroll") for (int k = 0; k < 2; ++k) dst[m][k] = *(const LAS bf16x8*)(lds + PG8_SA(b, h) + aoff + m * 2048 + k * 1024); } while (0)
#define PG8_LDB(dst, b, h) do { _Pragma("unroll") for (int n = 0; n < 2; ++n) _Pragma("unroll") for (int k = 0; k < 2; ++k) dst[n][k] = *(const LAS bf16x8*)(lds + PG8_SB(b, h) + boff + n * 2048 + k * 1024); } while (0)
#define PG8_MMA(ai, bj, At, Bt) do { __builtin_amdgcn_s_setprio(1); _Pragma("unroll") for (int m = 0; m < 4; ++m) _Pragma("unroll") for (int n = 0; n < 2; ++n) _Pragma("unroll") for (int k = 0; k < 2; ++k) \
        acc[ai][bj][m][n] = __builtin_amdgcn_mfma_f32_16x16x32_bf16(Bt[n][k], At[m][k], acc[ai][bj][m][n], 0, 0, 0); __builtin_amdgcn_s_setprio(0); } while (0)
#define PG8_WAIT_V(n) asm volatile("s_waitcnt vmcnt(" #n ")" ::: "memory")
#define PG8_WAIT_L(n) asm volatile("s_waitcnt lgkmcnt(" #n ")" ::: "memory")
#define PG8_BAR __builtin_amdgcn_s_barrier()
#define PG8_SCHED __builtin_amdgcn_sched_barrier(0)
    Unit cur, nxt; int ui = 0;
    if (!S.next(0, cur)) return;
    f32x4 acc[2][2][4][2];
#pragma unroll
    for (int a = 0; a < 2; ++a)
#pragma unroll
        for (int b = 0; b < 2; ++b)
#pragma unroll
            for (int m = 0; m < 4; ++m)
#pragma unroll
                for (int n = 0; n < 2; ++n) acc[a][b][m][n] = (f32x4){0.f, 0.f, 0.f, 0.f};
    bf16x8 At[4][2], B0[2][2], B1[2][2];
    const char* cA = (const char*)g.A + (size_t)cur.pm * tstepA + (size_t)cur.pn * g.acol * 2; const char* cB = (const char*)g.Bt + (size_t)cur.pn * tstepB;
    PG8_STAGE(PG8_SB(0, 0), cB, voffB); PG8_STAGE(PG8_SB(0, 1), cB + hstepB, voffB); PG8_STAGE(PG8_SA(0, 0), cA, voffA); PG8_STAGE(PG8_SA(0, 1), cA + hstepA, voffA);
    if (wr == 1) PG8_BAR;
    PG8_WAIT_V(2); PG8_BAR;
    PG8_STAGE(PG8_SB(1, 0), cB + kstep, voffB); PG8_STAGE(PG8_SA(1, 0), cA + kstep, voffA); PG8_STAGE(PG8_SB(1, 1), cB + hstepB + kstep, voffB);
    PG8_WAIT_V(6); PG8_BAR;
    for (;;) {
        const bool has_next = S.next(ui + 1, nxt);
        const char* nA = has_next ? (const char*)g.A + (size_t)nxt.pm * tstepA + (size_t)nxt.pn * g.acol * 2 : cA; const char* nB = has_next ? (const char*)g.Bt + (size_t)nxt.pn * tstepB : cB;
        for (int t = 0; t < nt; t += 2) {
            const bool last = (t == nt - 2);
            const char* a1 = cA + (size_t)(t + 1) * kstep;
            const char* a2 = last ? nA : cA + (size_t)(t + 2) * kstep; const char* b2 = last ? nB : cB + (size_t)(t + 2) * kstep;
            const char* a3 = a2 + kstep; const char* b3 = b2 + kstep;
            PG8_LDB(B0, 0, 0); PG8_LDB(B1, 0, 1); PG8_SCHED; PG8_LDA(At, 0, 0); PG8_STAGE(PG8_SA(1, 1), a1 + hstepA, voffA);
            PG8_WAIT_V(8); PG8_WAIT_L(0); PG8_BAR; PG8_MMA(0, 0, At, B0); PG8_MMA(0, 1, At, B1); PG8_BAR; PG8_SCHED;
            PG8_LDA(At, 0, 1); PG8_STAGE(PG8_SB(0, 0), b2, voffB); PG8_STAGE(PG8_SB(0, 1), b2 + hstepB, voffB); PG8_STAGE(PG8_SA(0, 0), a2, voffA);
            PG8_WAIT_V(8); PG8_WAIT_L(0); PG8_BAR; PG8_MMA(1, 0, At, B0); PG8_MMA(1, 1, At, B1); PG8_BAR; PG8_SCHED;
            PG8_LDB(B0, 1, 0); PG8_LDB(B1, 1, 1); PG8_SCHED; PG8_LDA(At, 1, 0); PG8_STAGE(PG8_SA(0, 1), a2 + hstepA, voffA);
            PG8_WAIT_V(8); PG8_WAIT_L(0); PG8_BAR; PG8_MMA(0, 0, At, B0); PG8_MMA(0, 1, At, B1); PG8_BAR; PG8_SCHED;
            PG8_LDA(At, 1, 1); PG8_STAGE(PG8_SB(1, 0), b3, voffB); PG8_STAGE(PG8_SB(1, 1), b3 + hstepB, voffB); PG8_STAGE(PG8_SA(1, 0), a3, voffA);
            PG8_WAIT_V(8); PG8_WAIT_L(0); PG8_BAR; PG8_MMA(1, 0, At, B0); PG8_MMA(1, 1, At, B1); PG8_BAR; PG8_SCHED;
        }
        if (wr == 0) PG8_BAR;
        E(acc, cur, wr, wc, fr, fq);
        if (!has_next) break;
#pragma unroll
        for (int a = 0; a < 2; ++a)
#pragma unroll
            for (int b = 0; b < 2; ++b)
#pragma unroll
                for (int m = 0; m < 4; ++m)
#pragma unroll
                    for (int n = 0; n < 2; ++n) acc[a][b][m][n] = (f32x4){0.f, 0.f, 0.f, 0.f};
        cur = nxt; cA = nA; cB = nB; ++ui;
        if (wr == 1) PG8_BAR;
    }
    PG8_WAIT_V(0);
    PG8_BAR;
#undef PG8_SA
#undef PG8_SB
#undef PG8_STAGE
#undef PG8_LDA
#undef PG8_LDB
#undef PG8_MMA
#undef PG8_WAIT_V
#undef PG8_WAIT_L
#undef PG8_BAR
#undef PG8_SCHED
}
}

__device__ __forceinline__ unsigned f2bf(float f) { unsigned u = __builtin_bit_cast(unsigned, f); return (u + 0x7fffu + ((u >> 16) & 1u)) >> 16; }
__device__ __forceinline__ unsigned pk2(float lo, float hi) { return f2bf(lo) | (f2bf(hi) << 16); }
__device__ __forceinline__ float bf2f(unsigned short v) { return __builtin_bit_cast(float, (unsigned)v << 16); }
__device__ __forceinline__ float wave_sum(float v) {
#pragma unroll
    for (int o = 1; o < 64; o <<= 1) v += __shfl_xor(v, o);
    return v;
}
#define LDS_WAIT() asm volatile("s_waitcnt lgkmcnt(0)" ::: "memory")

struct Args {
    const float* in[15];
    float* out; unsigned char* ws;
    int ph_lo, ph_hi;
};

__device__ __forceinline__ void tr_item(const float* W, int N, int nvalid, int sc0, int k0, const float* g, bf16_t* WT, int K, int n0, LAS float* scr, int lane, float cm = 1.0f) {
    const int nq = lane & 7, kr = lane >> 3;
#pragma unroll
    for (int i = 0; i < 8; ++i) { const int kk = i * 8 + kr, col = sc0 + 4 * nq;
        f32x4 v = (f32x4){0.f, 0.f, 0.f, 0.f};
        if (col + 3 < nvalid) v = *(const f32x4*)(W + (size_t)(k0 + kk) * N + col);
        if (g) v = v * (g[k0 + kk] * cm);
        LAS float* s = scr + kk * 33 + 4 * nq; s[0] = v[0]; s[1] = v[1]; s[2] = v[2]; s[3] = v[3]; }
    LDS_WAIT();
    const int c = lane & 7;
#pragma unroll
    for (int j = 0; j < 4; ++j) { const int n = (lane >> 3) + 8 * j; const LAS float* s = scr + (8 * c) * 33 + n;
        u32x4 o; o.x = pk2(s[0 * 33], s[1 * 33]); o.y = pk2(s[2 * 33], s[3 * 33]); o.z = pk2(s[4 * 33], s[5 * 33]); o.w = pk2(s[6 * 33], s[7 * 33]);
        *(u32x4*)(WT + (size_t)(n0 + n) * K + k0 + 8 * c) = o; }
    LDS_WAIT();
}

__device__ __forceinline__ void p0_prologue(const Args& a, LAS unsigned char* lds, int G) {
    const int tid = threadIdx.x, lane = tid & 63, wave = __builtin_amdgcn_readfirstlane(tid >> 6);
    LAS float* scr = (LAS float*)(lds + wave * 16384);
    const int gw = blockIdx.x * 8 + wave, NGW = G * 8;
    unsigned char* ws = a.ws;
    constexpr int I_IN = 16 * 176, I_OUT = 44 * 32, I_AI = 16 * 104, I_AO = 16 * 32, I_PL = 4 * 8;
    constexpr int NITEMS = 4 * I_IN + 4 * I_OUT + I_AI + I_AO + 4 * I_PL;
    for (int it = gw; it < NITEMS; it += NGW) {
        int r = it;
        if (r < 4 * I_IN) { const int mI = r / I_IN, q = r % I_IN, kb = q / 176, nb = q % 176, layer = mI >> 1, which = mI & 1;
            const float* W = (which ? a.in[7] : a.in[3]) + (size_t)layer * 1024 * 5632; const float* g = (which ? a.in[6] : a.in[2]) + layer * 1024;
            const int n0 = nb * 32, tile = n0 >> 8, within = n0 & 255, sc0 = within < 128 ? tile * 128 + within : DFF + tile * 128 + (within - 128);
            tr_item(W, 5632, 5632, sc0, kb * 64, g, (bf16_t*)(ws + WS_WIN + mI * WIN_BYTES), 1024, n0, scr, lane, within < 128 ? LOG2E : 1.0f / LOG2E); continue; }
        r -= 4 * I_IN;
        if (r < 4 * I_OUT) { const int mI = r / I_OUT, q = r % I_OUT, kb = q / 32, nb = q % 32, layer = mI >> 1, which = mI & 1;
            const float* W = (which ? a.in[8] : a.in[4]) + (size_t)layer * DFF * 1024;
            tr_item(W, 1024, 1024, nb * 32, kb * 64, nullptr, (bf16_t*)(ws + WS_WOUT + mI * WOUT_BYTES), DFF, nb * 32, scr, lane); continue; }
        r -= 4 * I_OUT;
        if (r < I_AI) { const int kb = r / 104, nb = r % 104;
            tr_item(a.in[9], 3080, 3080, nb * 32, kb * 64, a.in[5], (bf16_t*)(ws + WS_WAI), 1024, nb * 32, scr, lane); continue; }
        r -= I_AI;
        if (r < I_AO) { const int kb = r / 32, nb = r % 32;
            tr_item(a.in[11], 1024, 1024, nb * 32, kb * 64, nullptr, (bf16_t*)(ws + WS_WAO), 1024, nb * 32, scr, lane); continue; }
        r -= I_AO;
        { const int gI = r / I_PL, q = r % I_PL, kb = q / 8, nb = q % 8;
            tr_item(a.in[12] + (size_t)gI * 256 * 256, 256, 256, nb * 32, kb * 64, nullptr, (bf16_t*)(ws + WS_WPOOL) + (size_t)gI * 256 * 256, 256, nb * 32, scr, lane); }
    }
    float* hmeta = (float*)(ws + WS_HMETA); bf16_t* hb = (bf16_t*)(ws + WS_HB); float* ssq = (float*)(ws + WS_SSQ); bf16_t* ob = (bf16_t*)(ws + WS_OB);
    for (int row0 = gw; row0 < MP; row0 += 2 * NGW) {
        f32x4 v[2][4];
#pragma unroll
        for (int q = 0; q < 2; ++q) { const int row = row0 + q * NGW;
            const float* src = row < NREAL ? a.in[0] + (size_t)row * DM : (row < NREAL + NMETA ? a.in[1] + (size_t)(row - NREAL) * DM : nullptr);
#pragma unroll
            for (int j = 0; j < 4; ++j) v[q][j] = src ? ((const f32x4*)src)[64 * j + lane] : (f32x4){0.f, 0.f, 0.f, 0.f}; }
#pragma unroll
        for (int q = 0; q < 2; ++q) { const int row = row0 + q * NGW; if (row >= MP) break;
            float s = 0.f;
#pragma unroll
            for (int j = 0; j < 4; ++j) s += (v[q][j][0] * v[q][j][0] + v[q][j][1] * v[q][j][1]) + (v[q][j][2] * v[q][j][2] + v[q][j][3] * v[q][j][3]);
            s = wave_sum(s);
            float* hd = row < NREAL ? nullptr : hmeta + (size_t)(row - NREAL) * DM;
#pragma unroll
            for (int j = 0; j < 4; ++j) { if (hd) ((f32x4*)hd)[64 * j + lane] = v[q][j];
                u32x2 w; w.x = pk2(v[q][j][0], v[q][j][1]); w.y = pk2(v[q][j][2], v[q][j][3]); ((u32x2*)(hb + (size_t)row * DM))[64 * j + lane] = w;
                if (row >= NREAL + NMETA) ((u32x2*)(ob + (size_t)row * DM))[64 * j + lane] = (u32x2){0u, 0u}; }
            if (lane < 16) ssq[(size_t)row * 16 + lane] = lane == 0 ? s : 0.f;
            if (row >= MROW && row < MROW + NMETA) ((float*)(ws + WS_SSQM))[(row - MROW) * 64 + lane] = lane == 0 ? s : 0.f;
            if (row >= MROW + NMETA && row < MROW + 64) { u32x4* qp = (u32x4*)((bf16_t*)(ws + WS_BIG) + (size_t)row * DQKV); for (int j = lane; j < DQKV / 8; j += 64) qp[j] = (u32x4){0u, 0u, 0u, 0u}; }
        }
    }
}

namespace mt {
__device__ __forceinline__ float rstd_meta(const float* ssqm, int row) {
    const f32x4* p = (const f32x4*)(ssqm + row * 64); float s = 0.f;
#pragma unroll
    for (int i = 0; i < 16; ++i) { const f32x4 a = p[i]; s += (a[0] + a[1]) + (a[2] + a[3]); }
    return 1.0f / sqrtf(s * (1.0f / 1024.0f) + EPS);
}
template <int K>
__device__ __forceinline__ f32x4 dot(const bf16_t* A, int lda, const bf16_t* Bt, int n0, int wave, int lane) {
    const int fr = lane & 15, fq = lane >> 4; constexpr int KW = K / 8;
    const bf16_t* ap = A + (size_t)fr * lda + wave * KW + 8 * fq; const bf16_t* bp = Bt + (size_t)(n0 + fr) * K + wave * KW + 8 * fq;
    f32x4 acc = (f32x4){0.f, 0.f, 0.f, 0.f};
#pragma unroll
    for (int k = 0; k < KW; k += 32) { const bf16x8 av = *(const bf16x8*)(ap + k), bv = *(const bf16x8*)(bp + k); acc = __builtin_amdgcn_mfma_f32_16x16x32_bf16(bv, av, acc, 0, 0, 0); }
    return acc;
}
__device__ __forceinline__ f32x4 reduce8(LAS unsigned char* lds, f32x4 v, int slot, int wave, int lane) {
    LAS f32x4* red = (LAS f32x4*)lds + slot * 512;
    red[wave * 64 + lane] = v;
    __syncthreads();
    f32x4 s = red[lane];
#pragma unroll
    for (int w = 1; w < 8; ++w) s = s + red[w * 64 + lane];
    return s;
}
__device__ __forceinline__ void ffn_in(LAS unsigned char* lds, unsigned char* ws, int mI, int G) {
    const int tid = threadIdx.x, lane = tid & 63, wave = __builtin_amdgcn_readfirstlane(tid >> 6), fr = lane & 15, fq = lane >> 4;
    const bf16_t* hbm = (const bf16_t*)(ws + WS_HB) + (size_t)MROW * DM; const bf16_t* W = (const bf16_t*)(ws + WS_WIN + mI * WIN_BYTES);
    bf16_t* hid = (bf16_t*)(ws + WS_BIG) + (size_t)MROW * DFF;
    for (int jp = blockIdx.x; jp < 176; jp += G) { const int tile = jp >> 3, sub = jp & 7, ng = tile * 256 + sub * 16;
        const float rs_pre = rstd_meta((const float*)(ws + WS_SSQM), fr);
        f32x4 g = dot<1024>(hbm, DM, W, ng, wave, lane), u = dot<1024>(hbm, DM, W, ng + 128, wave, lane);
        __syncthreads();
        g = reduce8(lds, g, 0, wave, lane); u = reduce8(lds, u, 1, wave, lane);
        if (wave == 0) { const float rs = rs_pre; g = g * rs; u = u * rs;
            u32x2 w; w.x = pg8::cvt_pk_bf16(pg8::silu_mul2(g[0], u[0]), pg8::silu_mul2(g[1], u[1])); w.y = pg8::cvt_pk_bf16(pg8::silu_mul2(g[2], u[2]), pg8::silu_mul2(g[3], u[3]));
            *(u32x2*)(hid + (size_t)fr * DFF + tile * 128 + sub * 16 + 4 * fq) = w; } }
    __syncthreads();
}
template <int K>
__device__ __forceinline__ void resid(LAS unsigned char* lds, unsigned char* ws, const bf16_t* A, int lda, const bf16_t* W, float alpha, int G) {
    const int tid = threadIdx.x, lane = tid & 63, wave = __builtin_amdgcn_readfirstlane(tid >> 6), fr = lane & 15, fq = lane >> 4;
    float* hmeta = (float*)(ws + WS_HMETA); bf16_t* hbm = (bf16_t*)(ws + WS_HB) + (size_t)MROW * DM; float* ssqm = (float*)(ws + WS_SSQM);
    for (int jt = blockIdx.x; jt < 64; jt += G) {
        f32x4 acc = dot<K>(A, lda, W, 16 * jt, wave, lane);
        __syncthreads();
        acc = reduce8(lds, acc, 0, wave, lane);
        if (wave == 0) { const int c = 16 * jt + 4 * fq; float* hp = hmeta + (size_t)fr * DM + c;
            f32x4 hv = *(const f32x4*)hp; hv = hv + acc * alpha; *(f32x4*)hp = hv;
            u32x2 w; w.x = pg8::cvt_pk_bf16(hv[0], hv[1]); w.y = pg8::cvt_pk_bf16(hv[2], hv[3]); *(u32x2*)(hbm + (size_t)fr * DM + c) = w;
            float s = (hv[0] * hv[0] + hv[1] * hv[1]) + (hv[2] * hv[2] + hv[3] * hv[3]); s = pg8::fq_sum(s);
            if (fq == 0) ssqm[fr * 64 + jt] = s; } }
    __syncthreads();
}
__device__ __forceinline__ void attn_in(LAS unsigned char* lds, unsigned char* ws, const float* bf, int G) {
    const int tid = threadIdx.x, lane = tid & 63, wave = __builtin_amdgcn_readfirstlane(tid >> 6), fr = lane & 15, fq = lane >> 4;
    const bf16_t* hbm = (const bf16_t*)(ws + WS_HB) + (size_t)MROW * DM; const bf16_t* W = (const bf16_t*)(ws + WS_WAI);
    bf16_t* qkv = (bf16_t*)(ws + WS_BIG) + (size_t)MROW * DQKV; float* logf = (float*)(ws + WS_LOGF) + (size_t)MROW * 8;
    for (int jt = blockIdx.x; jt < 193; jt += G) {
        const float rs_pre = rstd_meta((const float*)(ws + WS_SSQM), fr);
        f32x4 acc = dot<1024>(hbm, DM, W, 16 * jt, wave, lane);
        __syncthreads();
        acc = reduce8(lds, acc, 0, wave, lane);
        if (wave == 0) { const float rs = rs_pre; const int c0 = 16 * jt + 4 * fq;
            if (jt < 192) { const float sc = ((c0 < 512) || (c0 >= 1536 && c0 < 2048)) ? rs * QSCALE : rs; const f32x4 v = acc * sc;
                u32x2 w; w.x = pg8::cvt_pk_bf16(v[0], v[1]); w.y = pg8::cvt_pk_bf16(v[2], v[3]); *(u32x2*)(qkv + (size_t)fr * DQKV + c0) = w; }
            else if (fq < 2) { const f32x4 x = acc * rs + *(const f32x4*)(bf + 4 * fq); f32x4 o;
#pragma unroll
                for (int i = 0; i < 4; ++i) { const float xv = x[i]; o[i] = fminf(xv, 0.f) * LOG2E - __builtin_amdgcn_logf(1.0f + __builtin_amdgcn_exp2f(-fabsf(xv) * LOG2E)); }
                *(f32x4*)(logf + (size_t)fr * 8 + 4 * fq) = o; } } }
    __syncthreads();
}
}

__device__ __forceinline__ void scan_phase(const Args& a, LAS unsigned char* lds, int G) {
    const int tid = threadIdx.x, lane = tid & 63, wave = __builtin_amdgcn_readfirstlane(tid >> 6);
    unsigned char* ws = a.ws;
    const float* logf = (const float*)(ws + WS_LOGF); float* c2 = (float*)(ws + WS_C2); float* c2m = (float*)(ws + WS_C2M);
    if (blockIdx.x < 32) {
        const int b = blockIdx.x >> 3, h = blockIdx.x & 7;
        LAS float* wtot = (LAS float*)lds;
        const float* lf = logf + ((size_t)b * SEQ + 16 * tid) * 8 + h;
        float v[16];
#pragma unroll
        for (int i = 0; i < 16; ++i) v[i] = lf[i * 8];
        float mt = 0.f;
        for (int j = 0; j < NMETA; ++j) { mt += logf[(size_t)(MROW + j) * 8 + h]; if (b == 0 && tid == 0) c2m[h * 16 + j] = mt; }
#pragma unroll
        for (int i = 1; i < 16; ++i) v[i] += v[i - 1];
        float inc = v[15];
#pragma unroll
        for (int o = 1; o < 64; o <<= 1) { const float t = __shfl_up(inc, o); if (lane >= o) inc += t; }
        if (lane == 63) wtot[wave] = inc;
        __syncthreads();
        float pre = mt + (inc - v[15]);
        for (int w = 0; w < wave; ++w) pre += wtot[w];
        f32x4* dst = (f32x4*)(c2 + ((size_t)(b * 8 + h) << 13) + 16 * tid);
#pragma unroll
        for (int i = 0; i < 4; ++i) dst[i] = (f32x4){v[4 * i] + pre, v[4 * i + 1] + pre, v[4 * i + 2] + pre, v[4 * i + 3] + pre};
    } else {
        const bf16_t* qkv = (const bf16_t*)(ws + WS_BIG);
        const int gw = (blockIdx.x - 32) * 8 + wave, NGW = (G - 32) * 8;
        float mx = 0.f;
        for (int row0 = gw; row0 < NREAL + NMETA; row0 += 4 * NGW) {
            u32x4 x0[4], x1[4];
#pragma unroll
            for (int q = 0; q < 4; ++q) { const int row = row0 + q * NGW < NREAL + NMETA ? row0 + q * NGW : row0;
                const u32x4* p = (const u32x4*)(qkv + (size_t)row * DQKV + 1536 + lane * 16); x0[q] = p[0]; x1[q] = p[1]; }
#pragma unroll
            for (int q = 0; q < 4; ++q) { float s = 0.f;
#pragma unroll
                for (int i = 0; i < 4; ++i) { const float a0 = __builtin_bit_cast(float, x0[q][i] << 16), a1 = __builtin_bit_cast(float, x0[q][i] & 0xffff0000u), b0 = __builtin_bit_cast(float, x1[q][i] << 16), b1 = __builtin_bit_cast(float, x1[q][i] & 0xffff0000u);
                    s += (a0 * a0 + a1 * a1) + (b0 * b0 + b1 * b1); }
                s += __shfl_xor(s, 1); s += __shfl_xor(s, 2);
                mx = fmaxf(mx, s); }
        }
        if ((lane & 3) == 0) atomicMax((unsigned*)(ws + WS_CTL) + (lane >> 5) * 8 + ((lane >> 2) & 7), __float_as_uint(mx));
    }
}

namespace att {
constexpr int KROW = 144, TILEB = 64 * KROW;
constexpr int L_K = 0, L_V = 4 * TILEB, L_CK = 8 * TILEB, L_WSF = L_CK + 1024, L_FLAG = L_WSF + 8 * 256;
__device__ __forceinline__ int crow(int r, int hi) { return (r & 3) + 8 * (r >> 2) + 4 * hi; }
typedef short v4i16_t __attribute__((ext_vector_type(4)));
__device__ __forceinline__ s16x4 vtr(LAS const unsigned char* p) { return __builtin_bit_cast(s16x4, __builtin_amdgcn_ds_read_tr16_b64_v4i16((LAS v4i16_t*)p)); }
__device__ __forceinline__ float swap_sum(float v) { auto rr = __builtin_amdgcn_permlane32_swap(__float_as_uint(v), __float_as_uint(v), false, false); return __uint_as_float(rr[0]) + __uint_as_float(rr[1]); }
__device__ __forceinline__ float swap_max(float v) { auto rr = __builtin_amdgcn_permlane32_swap(__float_as_uint(v), __float_as_uint(v), false, false); return fmaxf(__uint_as_float(rr[0]), __uint_as_float(rr[1])); }

template <bool FOX>
__device__ __forceinline__ void unit(LAS unsigned char* lds, const bf16_t* __restrict__ qkv, const float* __restrict__ c2, const float* __restrict__ c2m, float Bh, bf16_t* ob, int b, int h, int qblk) {
    const int tid = threadIdx.x, lane = tid & 63, r32 = lane & 31, hi = lane >> 5, w = __builtin_amdgcn_readfirstlane(tid >> 6);
    const bool meta = qblk < 0;
    const int qrow0 = meta ? MROW : b * SEQ + qblk * 256;
    const int qpos0 = meta ? 0 : NMETA + qblk * 256;
    const int NT = meta ? 0 : 4 * qblk + 4, ntile = NT + 1;
    const int qcol = (FOX ? 1536 : 0) + h * 64, kcol = qcol + 512, vcol = qcol + 1024, ocol = (FOX ? 512 : 0) + h * 64;
    const int qrow = qrow0 + 32 * w + r32, qpos = qpos0 + 32 * w + r32, wqmax = qpos0 + 32 * w + 31;
    const float* c2bh = c2 + ((size_t)(b * 8 + h) << 13);
    bf16x8 qf[4];
#pragma unroll
    for (int d0 = 0; d0 < 4; ++d0) qf[d0] = *(const bf16x8*)(qkv + (size_t)qrow * DQKV + qcol + d0 * 16 + hi * 8);
    float cfirst = 0.f;
    if (FOX) cfirst = meta ? 0.f : c2bh[qblk * 256];
    const int skey = tid >> 3, sch = tid & 7;
    LAS float* wsf = (LAS float*)(lds + L_WSF) + w * 64;
    LAS unsigned* flag = (LAS unsigned*)(lds + L_FLAG);
    u32x4 kreg0, vreg0, kreg1, vreg1; float ckreg0 = 0.f, ckreg1 = 0.f;
#define ATT_LOAD(idx, S) do { const int _j = NT - 1 - (idx); const int _r0 = (_j >= 0) ? b * SEQ + 64 * _j : MROW; \
        const bf16_t* _p = qkv + (size_t)(_r0 + skey) * DQKV + sch * 8; kreg##S = *(const u32x4*)(_p + kcol); vreg##S = *(const u32x4*)(_p + vcol); \
        if (FOX && tid < 64) ckreg##S = (_j >= 0) ? c2bh[64 * _j + tid] : c2m[h * 16 + (tid & 15)]; } while (0)
#define ATT_STORE(buf, S) do { *(LAS u32x4*)(lds + L_K + (buf) * TILEB + skey * KROW + sch * 16) = kreg##S; *(LAS u32x4*)(lds + L_V + (buf) * TILEB + skey * KROW + sch * 16) = vreg##S; \
        if (FOX && tid < 64) ((LAS float*)(lds + L_CK + (buf) * 256))[tid] = ckreg##S; } while (0)
    ATT_LOAD(0, 0); if (ntile > 1) ATT_LOAD(1, 1);
    ATT_STORE(0, 0); if (ntile > 1) ATT_STORE(1, 1);
    __syncthreads();
    f32x16 o[2]; o[0] = f32x16{}; o[1] = f32x16{};
    float R = 0.f;
    f32x16 osum = f32x16{};
    const bf16x8 ones8 = (bf16x8){16256, 16256, 16256, 16256, 16256, 16256, 16256, 16256};
    f32x16 negm = f32x16{}; asm volatile("" : "+v"(negm));
    bool started = false, wdone = false;
    const int vlane = (4 * hi + ((lane & 15) >> 2)) * KROW + (((lane >> 4) & 1) * 16 + (lane & 3) * 4) * 2;
    for (int it = 0;; ++it) {
        const int base = 2 * it, pb = (it & 1) * 2, nb = base + 2;
        bool more = nb < ntile;
        if (FOX && more && nb >= 4) { const int j1 = NT - 1 - nb; const float cl = (j1 >= 0) ? c2bh[64 * j1 + 63] : c2m[h * 16 + 15]; if (cfirst - cl + Bh < THR2) more = false; }
        const bool more1 = more && nb + 1 < ntile;
        if (more) ATT_LOAD(nb, 0);
        if (more1) ATT_LOAD(nb + 1, 1);
#pragma unroll
        for (int sub = 0; sub < 2; ++sub) {
        const int idx = base + sub, cur = pb + sub;
        if (idx >= ntile) break;
        const int j = NT - 1 - idx, tpos0 = (j >= 0) ? NMETA + 64 * j : 0, nvalid = (j >= 0) ? 64 : NMETA;
        if (tpos0 <= wqmax && !wdone && (!meta || w == 0)) {
            started = true;
            const LAS unsigned char* kb = lds + L_K + cur * TILEB + r32 * KROW + hi * 16;
            f32x16 p[2];
#pragma unroll
            for (int d0 = 0; d0 < 4; ++d0) {
                const bf16x8 k0 = *(const LAS bf16x8*)(kb + d0 * 32), k1 = *(const LAS bf16x8*)(kb + 32 * KROW + d0 * 32);
                if (d0 == 0) { p[0] = __builtin_amdgcn_mfma_f32_32x32x16_bf16(k0, qf[0], negm, 0, 0, 0); p[1] = __builtin_amdgcn_mfma_f32_32x32x16_bf16(k1, qf[0], negm, 0, 0, 0); }
                else { p[0] = __builtin_amdgcn_mfma_f32_32x32x16_bf16(k0, qf[d0], p[0], 0, 0, 0); p[1] = __builtin_amdgcn_mfma_f32_32x32x16_bf16(k1, qf[d0], p[1], 0, 0, 0); }
            }
            int lim = (FOX ? qpos - tpos0 : qpos - tpos0 - 1); lim = lim < nvalid - 1 ? lim : nvalid - 1;
            const int limh = lim - 4 * hi;
            if (FOX) {
                const LAS float* ckp = (const LAS float*)(lds + L_CK + cur * 256) + 4 * hi;
                const bool fullt = (tpos0 + 63 <= qpos0 + 32 * w) && nvalid == 64;
                float mt = -1e30f;
                if (fullt) {
#pragma unroll
                    for (int half = 0; half < 2; ++half)
#pragma unroll
                        for (int g = 0; g < 4; ++g) { const f32x4 ck = *(const LAS f32x4*)(ckp + 32 * half + 8 * g);
#pragma unroll
                            for (int i = 0; i < 4; ++i) { const int r = 4 * g + i; const float sv = p[half][r] - ck[i]; p[half][r] = sv; mt = fmaxf(mt, sv); } }
                } else {
#pragma unroll
                    for (int half = 0; half < 2; ++half)
#pragma unroll
                        for (int g = 0; g < 4; ++g) { const f32x4 ck = *(const LAS f32x4*)(ckp + 32 * half + 8 * g);
#pragma unroll
                            for (int i = 0; i < 4; ++i) { const int r = 4 * g + i; float sv = p[half][r] - ck[i]; sv = (32 * half + 8 * g + i <= limh) ? sv : -1e30f; p[half][r] = sv; mt = fmaxf(mt, sv); } }
                }
                mt = swap_max(mt);
                if (__any(mt > 6.0f)) {
                    const float dl = fmaxf(mt, 0.f); R += dl;
#pragma unroll
                    for (int half = 0; half < 2; ++half)
#pragma unroll
                        for (int r = 0; r < 16; ++r) p[half][r] -= dl;
#pragma unroll
                    for (int r = 0; r < 16; ++r) negm[r] = -R;
                    asm volatile("" : "+v"(negm));
                    const float sc = __builtin_amdgcn_exp2f(-dl);
                    if (hi == 0) wsf[r32] = sc;
                    LDS_WAIT();
#pragma unroll
                    for (int g = 0; g < 4; ++g) { const f32x4 f = *(const LAS f32x4*)(wsf + 8 * g + 4 * hi);
#pragma unroll
                        for (int i = 0; i < 4; ++i) { o[0][4 * g + i] *= f[i]; o[1][4 * g + i] *= f[i]; osum[4 * g + i] *= f[i]; } }
                }
#pragma unroll
                for (int half = 0; half < 2; ++half)
#pragma unroll
                    for (int r = 0; r < 16; ++r) p[half][r] = __builtin_amdgcn_exp2f(p[half][r]);
            } else {
                const bool fullt = (tpos0 + 64 <= qpos0 + 32 * w) && nvalid == 64;
                float T[2][4], Gs[2][4];
#define SB_PASS1(MASKED) _Pragma("unroll") for (int half = 0; half < 2; ++half) _Pragma("unroll") for (int g = 0; g < 4; ++g) { float lsv[4]; \
                    _Pragma("unroll") for (int i = 0; i < 4; ++i) { const float z = fminf(p[half][4 * g + i], 126.0f); p[half][4 * g + i] = z; \
                        const float ls = -__builtin_amdgcn_logf(1.0f + __builtin_amdgcn_exp2f(z));        \
                        lsv[i] = (!(MASKED) || (32 * half + 8 * g + i <= limh)) ? ls : 0.f; } \
                    const float s3 = lsv[3], s2 = s3 + lsv[2], s1 = s2 + lsv[1], s0 = s1 + lsv[0]; \
                    Gs[half][g] = s0; T[half][g] = swap_sum(s0); \
                    p[half][4 * g + 0] += s0; p[half][4 * g + 1] += s1; p[half][4 * g + 2] += s2; p[half][4 * g + 3] += s3; }
#define SB_PASS2(MASKED) { float suf = R; _Pragma("unroll") for (int half = 1; half >= 0; --half) _Pragma("unroll") for (int g = 3; g >= 0; --g) { \
                    const float off = suf + (hi == 0 ? T[half][g] - Gs[half][g] : 0.f); \
                    _Pragma("unroll") for (int i = 0; i < 4; ++i) { float e = __builtin_amdgcn_exp2f(p[half][4 * g + i] + off); e = (!(MASKED) || (32 * half + 8 * g + i <= limh)) ? e : 0.f; p[half][4 * g + i] = e; } \
                    suf += T[half][g]; } R = suf; }
                if (fullt) { SB_PASS1(false) SB_PASS2(false) } else { SB_PASS1(true) SB_PASS2(true) }
#undef SB_PASS1
#undef SB_PASS2
            }
            const LAS unsigned char* vb = lds + L_V + cur * TILEB + vlane;
#pragma unroll
            for (int half = 0; half < 2; ++half)
#pragma unroll
                for (int s = 0; s < 2; ++s) {
                    u32x4 pw; pw.x = pg8::cvt_pk_bf16(p[half][8 * s + 0], p[half][8 * s + 1]); pw.y = pg8::cvt_pk_bf16(p[half][8 * s + 2], p[half][8 * s + 3]);
                    pw.z = pg8::cvt_pk_bf16(p[half][8 * s + 4], p[half][8 * s + 5]); pw.w = pg8::cvt_pk_bf16(p[half][8 * s + 6], p[half][8 * s + 7]);
                    const bf16x8 pa = __builtin_bit_cast(bf16x8, pw);
                    if (FOX) osum = __builtin_amdgcn_mfma_f32_32x32x16_bf16(pa, ones8, osum, 0, 0, 0);
#pragma unroll
                    for (int d0 = 0; d0 < 2; ++d0) {
                        const s16x4 lo = vtr(vb + (32 * half + 16 * s) * KROW + d0 * 64), hh = vtr(vb + (32 * half + 16 * s + 8) * KROW + d0 * 64);
                        const bf16x8 vf = (bf16x8){lo[0], lo[1], lo[2], lo[3], hh[0], hh[1], hh[2], hh[3]};
                        o[d0] = __builtin_amdgcn_mfma_f32_32x32x16_bf16(pa, vf, o[d0], 0, 0, 0);
                    }
                }
            if (!FOX) { wdone = __all(R < THR2); }
        }
        }
        if (more) ATT_STORE((pb ^ 2), 0);
        if (more1) ATT_STORE((pb ^ 2) + 1, 1);
        const int fpar = it & 1;
        if (!FOX && lane == 0) flag[fpar * 8 + w] = (started && wdone) ? 1u : 0u;
        __syncthreads();
        if (!more) break;
        if (!FOX) { const u32x4 f0 = *(const LAS u32x4*)(flag + fpar * 8), f1 = *(const LAS u32x4*)(flag + fpar * 8 + 4);
            if ((f0.x & f0.y & f0.z & f0.w & f1.x & f1.y & f1.z & f1.w) != 0u) break; }
    }
    if (FOX) {
#pragma unroll
        for (int r = 0; r < 16; ++r) { const float inv = __builtin_amdgcn_rcpf(osum[r]); o[0][r] *= inv; o[1][r] *= inv; }
    }
    if (!meta || w == 0) {
#pragma unroll
        for (int r = 0; r < 16; ++r) { const int rr = crow(r, hi);
            if (!meta || rr < NMETA) { bf16_t* op = ob + (size_t)(qrow0 + 32 * w + rr) * DM + ocol + r32;
                op[0] = (bf16_t)f2bf(o[0][r]); op[32] = (bf16_t)f2bf(o[1][r]); } }
    }
    asm volatile("s_waitcnt lgkmcnt(0)\n\ts_barrier" ::: "memory");
#undef ATT_LOAD
#undef ATT_STORE
}
}

__device__ __forceinline__ void attn_phase(const Args& a, LAS unsigned char* lds, int G) {
    unsigned char* ws = a.ws;
    const bf16_t* qkv = (const bf16_t*)(ws + WS_BIG); const float* c2 = (const float*)(ws + WS_C2); const float* c2m = (const float*)(ws + WS_C2M);
    const float* ctl = (const float*)(ws + WS_CTL); bf16_t* ob = (bf16_t*)(ws + WS_OB);
    unsigned* ready = (unsigned*)(ws + WS_CTL) + 64;
    scan_phase(a, lds, G);
    asm volatile("s_waitcnt vmcnt(0)" ::: "memory");
    __syncthreads();
    if (threadIdx.x == 0) { __builtin_amdgcn_fence(__ATOMIC_RELEASE, "agent"); asm volatile("s_waitcnt vmcnt(0)" ::: "memory"); __hip_atomic_fetch_add(ready, 1u, __ATOMIC_RELAXED, __HIP_MEMORY_SCOPE_AGENT); }
    const bool short_cu = (blockIdx.x & 31) == 0;
    for (int i = 0; i * G < 1024; ++i) { const int id = i * G + blockIdx.x; if (id >= 1024) break;
        const int qblk = id & 31, bh = id >> 5; att::unit<false>(lds, qkv, c2, c2m, 0.f, ob, bh >> 3, bh & 7, qblk); }
    if (short_cu && (blockIdx.x >> 5) < 8) att::unit<false>(lds, qkv, c2, c2m, 0.f, ob, 0, blockIdx.x >> 5, -1);
    if (threadIdx.x == 0) { unsigned sp = 0u;
        while (__hip_atomic_load(ready, __ATOMIC_RELAXED, __HIP_MEMORY_SCOPE_AGENT) < (unsigned)G) { __builtin_amdgcn_s_sleep(2); if (++sp > (1u << 22)) break; }
        __builtin_amdgcn_fence(__ATOMIC_ACQUIRE, "agent"); asm volatile("s_waitcnt vmcnt(0)" ::: "memory"); }
    __syncthreads();
    for (int i = 0; i * G < 1024; ++i) { const int id = i * G + blockIdx.x; if (id >= 1024) break;
        const int qblk = id & 31, bh = id >> 5, h = bh & 7; const float Bh = 2.002f * sqrtf(ctl[h] * ctl[8 + h]);
        att::unit<true>(lds, qkv, c2, c2m, Bh, ob, bh >> 3, h, qblk); }
    if (short_cu && (blockIdx.x >> 5) < 8) att::unit<true>(lds, qkv, c2, c2m, 0.f, ob, 0, blockIdx.x >> 5, -1);
}

template <int W>
__device__ __forceinline__ void pool_rows(const bf16_t* __restrict__ hbp, const float* __restrict__ hmeta, bf16_t* __restrict__ pb, const LAS float* rs, f32x4 gv, int b, int start, int rs0, int cidx) {
    constexpr int K0 = 16 - W;
    u32x2 raw[47];
#pragma unroll
    for (int k = K0; k < 47; ++k) { const int pos = start - 15 + k;
        if (pos < NMETA) { const f32x4 v = *(const f32x4*)(hmeta + (size_t)pos * DM + 4 * cidx); raw[k].x = pk2(v[0], v[1]); raw[k].y = pk2(v[2], v[3]); }
        else raw[k] = *(const u32x2*)(hbp + (size_t)(b * SEQ + pos - NMETA) * DM + 4 * cidx); }
#define POOL_UK(k) ((f32x4){__builtin_bit_cast(float, raw[k].x << 16), __builtin_bit_cast(float, raw[k].x & 0xffff0000u), __builtin_bit_cast(float, raw[k].y << 16), __builtin_bit_cast(float, raw[k].y & 0xffff0000u)} * gv * rs[rs0 + (k)])
    f32x4 S = (f32x4){0.f, 0.f, 0.f, 0.f};
#pragma unroll
    for (int i = 1; i < W; ++i) S = S + POOL_UK(15 - i);
    constexpr float invw = 1.0f / (float)W;
#pragma unroll
    for (int r = 0; r < 32; ++r) {
        const f32x4 un = POOL_UK(15 + r); S = S + un;
        const f32x4 o = S * invw - un;
        u32x2 pk; pk.x = pk2(o[0], o[1]); pk.y = pk2(o[2], o[3]);
        *(u32x2*)(pb + (size_t)(b * SEQ + start + r - NMETA) * DM + 4 * cidx) = pk;
        S = S - POOL_UK(15 + r - W + 1); }
#undef POOL_UK
}
__device__ __forceinline__ void pool_phase(const Args& a, LAS unsigned char* lds, int G) {
    unsigned char* ws = a.ws;
    const float* hmeta = (const float*)(ws + WS_HMETA); const float* ssq = (const float*)(ws + WS_SSQ); bf16_t* pb = (bf16_t*)(ws + WS_OB);
    const float* gm = a.in[5] + 1024;
    const bf16_t* hbp = (const bf16_t*)(ws + WS_HB);
    const int tid = threadIdx.x, cidx = tid & 255, half = tid >> 8, grp = cidx >> 6;
    const f32x4 gv = *(const f32x4*)(gm + 4 * cidx);
    LAS float* rs = (LAS float*)lds;
    for (int tile = blockIdx.x; tile < NREAL / 64; tile += G) {
        const int b = tile >> 7, t0 = (tile & 127) * 64, pos0 = NMETA + t0;
        __syncthreads();
        if (tid < 79) { const int pos = pos0 - 15 + tid; const int row = pos < NMETA ? MROW + pos : b * SEQ + pos - NMETA; rs[tid] = pos < NMETA ? mt::rstd_meta((const float*)(ws + WS_SSQM), pos) : pg8::row_rstd(ssq, row); }
        __syncthreads();
        const int start = pos0 + 32 * half;
        switch (grp) {
        case 0: pool_rows<2>(hbp, hmeta, pb, rs, gv, b, start, 32 * half, cidx); break;
        case 1: pool_rows<4>(hbp, hmeta, pb, rs, gv, b, start, 32 * half, cidx); break;
        case 2: pool_rows<8>(hbp, hmeta, pb, rs, gv, b, start, 32 * half, cidx); break;
        default: pool_rows<16>(hbp, hmeta, pb, rs, gv, b, start, 32 * half, cidx); break;
        }
    }
}

__device__ __forceinline__ void final_phase(const Args& a, int G) {
    const int tid = threadIdx.x, lane = tid & 63, wave = tid >> 6;
    const int gw = blockIdx.x * 8 + wave, NGW = G * 8;
    const float* gf = a.in[14]; const bf16_t* hb = (const bf16_t*)(a.ws + WS_HB);
    f32x4 gv[4];
#pragma unroll
    for (int j = 0; j < 4; ++j) gv[j] = ((const f32x4*)gf)[64 * j + lane];
    for (int row0 = gw; row0 < NREAL; row0 += 2 * NGW) {
        u32x2 wv[2][4];
#pragma unroll
        for (int q = 0; q < 2; ++q) { const int row = row0 + q * NGW < NREAL ? row0 + q * NGW : row0; const u32x2* hp = (const u32x2*)(hb + (size_t)row * DM);
#pragma unroll
            for (int j = 0; j < 4; ++j) wv[q][j] = hp[64 * j + lane]; }
#pragma unroll
        for (int q = 0; q < 2; ++q) { const int row = row0 + q * NGW; if (row >= NREAL) break;
            f32x4 v[4]; float s = 0.f;
#pragma unroll
            for (int j = 0; j < 4; ++j) { const u32x2 w = wv[q][j];
                v[j] = (f32x4){__builtin_bit_cast(float, w.x << 16), __builtin_bit_cast(float, w.x & 0xffff0000u), __builtin_bit_cast(float, w.y << 16), __builtin_bit_cast(float, w.y & 0xffff0000u)};
                s += (v[j][0] * v[j][0] + v[j][1] * v[j][1]) + (v[j][2] * v[j][2] + v[j][3] * v[j][3]); }
            s = wave_sum(s);
            const float rstd = 1.0f / sqrtf(s * (1.0f / 1024.0f) + EPS);
            f32x4* op = (f32x4*)(a.out + (size_t)row * DM);
#pragma unroll
            for (int j = 0; j < 4; ++j) op[64 * j + lane] = v[j] * rstd * gv[j];
        }
    }
}

#define XB_TMO      128
#define XB_XCNT(j)  (256  + 64 * (j))
#define XB_XSUB(j)  (1280 + 64 * (j))
#define XB_XGEN(j)  (2304 + 64 * (j))
#define XB_TOP      3328
#define XB_TOPGEN   3392
#define XCD_BAR_WORDS 3456
#define XB_SPIN_CAP (1u << 18)
__device__ __forceinline__ unsigned xb_ld(unsigned* p)              { return __hip_atomic_load(p, __ATOMIC_RELAXED, __HIP_MEMORY_SCOPE_AGENT); }
__device__ __forceinline__ unsigned xb_add(unsigned* p, unsigned v) { return __hip_atomic_fetch_add(p, v, __ATOMIC_RELAXED, __HIP_MEMORY_SCOPE_AGENT); }
__device__ __forceinline__ unsigned xb_xcc_id() { return (unsigned)__builtin_amdgcn_s_getreg((3 << 11) | 20) & 0xFu; }
#define XB_SPIN(cond, bar) do { unsigned _sp = 0; while (cond) { __builtin_amdgcn_s_sleep(1); \
    if ((++_sp & 255u) == 0u) { if (xb_ld(&(bar)[XB_TMO])) break; if (_sp > XB_SPIN_CAP) { atomicAdd(&(bar)[XB_TMO], 1u); break; } } } } while (0)
struct XcdBarrier { unsigned* bar; unsigned x; volatile LAS unsigned* st; };
__device__ __forceinline__ XcdBarrier xcd_barrier_post(unsigned* bar, volatile LAS unsigned* st) {
    XcdBarrier b; b.bar = bar; b.x = xb_xcc_id(); b.st = st;
    if (threadIdx.x == 0) (void)xb_add(&bar[XB_XCNT(b.x)], 1u);
    return b;
}
__device__ __forceinline__ void xcd_barrier_complete(unsigned* bar, unsigned x, unsigned& nloc, unsigned& nx) {
    const unsigned G = gridDim.x * gridDim.y * gridDim.z;
    unsigned sum, cnt, mine, sp = 0u;
    for (;;) {
        sum = 0u; cnt = 0u; mine = 0u;
#pragma unroll
        for (unsigned j = 0; j < 16; ++j) { const unsigned c = xb_ld(&bar[XB_XCNT(j)]); sum += c; cnt += (c > 0u) ? 1u : 0u; mine = (j == x) ? c : mine; }
        if (sum == G) break;
        __builtin_amdgcn_s_sleep(1);
        if ((++sp & 255u) == 0u) { if (xb_ld(&bar[XB_TMO])) break; if (sp > XB_SPIN_CAP) { atomicAdd(&bar[XB_TMO], 1u); break; } }
    }
    nloc = mine > 0u ? mine : 1u; nx = cnt > 0u ? cnt : 1u;
}
__device__ __forceinline__ void xcd_barrier(const XcdBarrier& b) {
    asm volatile("s_waitcnt vmcnt(0)" ::: "memory");
    __syncthreads();
    if (threadIdx.x == 0) {
        unsigned* bar = b.bar;
        __builtin_amdgcn_s_waitcnt(0);
        unsigned nloc = b.st[0], nx = b.st[1];
        if (nloc == 0u) { xcd_barrier_complete(bar, b.x, nloc, nx); b.st[0] = nloc; b.st[1] = nx; }
        const unsigned old = xb_add(&bar[XB_XSUB(b.x)], 1u);
        const unsigned gen = old / nloc;
        if (old + 1u == (gen + 1u) * nloc) {
            __builtin_amdgcn_fence(__ATOMIC_RELEASE, "agent");
            asm volatile("s_waitcnt vmcnt(0)" ::: "memory");
            const unsigned og = xb_add(&bar[XB_TOP], 1u);
            const unsigned tg = og / nx;
            if (og + 1u == (tg + 1u) * nx) xb_add(&bar[XB_TOPGEN], 1u);
            else XB_SPIN(xb_ld(&bar[XB_TOPGEN]) == tg, bar);
            __builtin_amdgcn_fence(__ATOMIC_ACQUIRE, "agent");
            xb_add(&bar[XB_XGEN(b.x)], 1u);
            asm volatile("s_waitcnt vmcnt(0)" ::: "memory");
        } else {
            XB_SPIN(xb_ld(&bar[XB_XGEN(b.x)]) == gen, bar);
            __builtin_amdgcn_fence(__ATOMIC_ACQUIRE, "agent");
            asm volatile("s_waitcnt vmcnt(0)" ::: "memory");
        }
    }
    __syncthreads();
}

constexpr int N_PHASES = 16;
#ifndef PHMASK
#define PHMASK 0xFFFF
#endif
#define PH_ON(k) ((PHMASK >> (k)) & 1)
__global__ void __launch_bounds__(512, 2) fwd_kernel(Args a) {
    extern __shared__ __attribute__((aligned(16))) unsigned char lds_raw[];
    LAS unsigned char* lds = (LAS unsigned char*)lds_raw;
    const int G = gridDim.x;
    unsigned char* ws = a.ws;
    bf16_t* hb = (bf16_t*)(ws + WS_HB); float* ssq = (float*)(ws + WS_SSQ); float* hmeta = (float*)(ws + WS_HMETA); bf16_t* ob = (bf16_t*)(ws + WS_OB);
    bf16_t* big = (bf16_t*)(ws + WS_BIG);
    const int lo = a.ph_lo, hi = a.ph_hi;
    volatile LAS unsigned* bst = (volatile LAS unsigned*)(lds + LDS_MISC);
    if (threadIdx.x < 2) bst[threadIdx.x] = 0u;
    __syncthreads();
    XcdBarrier xbar; xbar.bar = (unsigned*)(ws + WS_CTL + CTL_BAR); xbar.x = 0; xbar.st = bst;
    if (ONE_LAUNCH) xbar = xcd_barrier_post((unsigned*)(ws + WS_CTL + CTL_BAR), bst);
#define IN(k) (PH_ON(k) && lo <= (k) && (k) < hi)
#define SEAM(k) do { if (ONE_LAUNCH && lo <= (k) && (k) + 1 < hi) xcd_barrier(xbar); } while (0)
#define FFN_IN(k, mI, M_) do { if (IN(k)) { if ((M_) == MP) mt::ffn_in(lds, ws, (mI), G); pg8::Gemm g{hb, (const bf16_t*)(ws + WS_WIN + (mI) * WIN_BYTES), NREAL, 5632, 1024, 1024, 1024, 0}; pg8::StaticOrder S; S.init(NREAL, 5632, G, blockIdx.x); \
        pg8::EpiSwiGLU E{big, ssq}; pg8::gemm_phase(lds, g, S, E); } SEAM(k); } while (0)
#define FFN_OUT(k, mI, M_, WHB) do { if (IN(k)) { if ((M_) == MP) mt::resid<DFF>(lds, ws, big + (size_t)MROW * DFF, DFF, (const bf16_t*)(ws + WS_WOUT + (mI) * WOUT_BYTES), 0.5f, G); pg8::Gemm g{big, (const bf16_t*)(ws + WS_WOUT + (mI) * WOUT_BYTES), NREAL, 1024, DFF, DFF, DFF, 0}; pg8::StaticOrder S; S.init(NREAL, 1024, G, blockIdx.x); \
        pg8::EpiResid E{a.out, hb, ssq, nullptr, 0.5f, (WHB) ? 0 : 1}; pg8::gemm_phase(lds, g, S, E); } SEAM(k); } while (0)
    if (ONE_LAUNCH && lo < 0) cg::this_grid().sync();
    if (IN(0)) p0_prologue(a, lds, G);
    SEAM(0);
    FFN_IN(1, 0, MP);
    FFN_OUT(2, 0, MP, 1);
    if (IN(3)) {
        mt::attn_in(lds, ws, a.in[10], G);
        pg8::Gemm g{hb, (const bf16_t*)(ws + WS_WAI), NREAL, NATT, 1024, 1024, 1024, 0}; pg8::StaticOrder S; S.init(NREAL, NATT, G, blockIdx.x);
        pg8::EpiQKV E{big, (float*)(ws + WS_LOGF), ssq, a.in[10]}; pg8::gemm_phase(lds, g, S, E); }
    SEAM(3);
    if (IN(5)) attn_phase(a, lds, G);
    SEAM(5);
    if (IN(6)) {
        mt::resid<1024>(lds, ws, ob + (size_t)MROW * DM, DM, (const bf16_t*)(ws + WS_WAO), 1.0f, G);
        pg8::Gemm g{ob, (const bf16_t*)(ws + WS_WAO), NREAL, 1024, 1024, 1024, 1024, 0}; pg8::StaticOrder S; S.init(NREAL, 1024, G, blockIdx.x);
        pg8::EpiResid E{a.out, hb, ssq, nullptr, 1.0f, 0}; pg8::gemm_phase(lds, g, S, E); }
    SEAM(6);
    FFN_IN(7, 1, MP);
    FFN_OUT(8, 1, MP, 1);
    FFN_IN(9, 2, MP);
    FFN_OUT(10, 2, MP, 1);
    if (IN(11)) pool_phase(a, lds, G);
    SEAM(11);
    if (IN(12)) {
        pg8::Gemm g{ob, (const bf16_t*)(ws + WS_WPOOL), NREAL, 1024, 256, 1024, 256, 256}; pg8::StaticOrder S; S.init(NREAL, 1024, G, blockIdx.x);
        pg8::EpiResid E{a.out, hb, ssq, a.in[13], 1.0f, 0}; pg8::gemm_phase(lds, g, S, E); }
    SEAM(12);
    FFN_IN(13, 3, NREAL);
    FFN_OUT(14, 3, NREAL, 1);
    if (IN(15)) final_phase(a, G);
#undef IN
#undef SEAM
}

extern "C" void kernel_launch(void* const* d_in, const int* in_sizes, int n_in, void* d_out, int out_size, void* d_ws, size_t ws_size, hipStream_t stream) {
    static int grid = 0;
    if (grid == 0) {
        if (n_in != 15 || out_size != NREAL * DM || ws_size < WS_END) { fprintf(stderr, "kernel_launch: unexpected shapes (n_in %d out %d ws %zu need %zu)\n", n_in, out_size, ws_size, (size_t)WS_END); grid = -1; return; }
        int dev = 0, cus = 0;
        if (hipGetDevice(&dev) != hipSuccess || hipDeviceGetAttribute(&cus, hipDeviceAttributeMultiprocessorCount, dev) != hipSuccess) { grid = -1; return; }
        if (hipFuncSetAttribute((const void*)fwd_kernel, hipFuncAttributeMaxDynamicSharedMemorySize, LDS_BYTES) != hipSuccess) { fprintf(stderr, "kernel_launch: hipFuncSetAttribute failed\n"); grid = -1; return; }
        int per_cu = 0;
        if (hipOccupancyMaxActiveBlocksPerMultiprocessor(&per_cu, (const void*)fwd_kernel, 512, LDS_BYTES) != hipSuccess || per_cu < 1) { fprintf(stderr, "kernel_launch: occupancy query says %d\n", per_cu); }
        (void)hipGetLastError();
        grid = cus;
    }
    if (grid < 0) return;
    (void)hipMemsetAsync((char*)d_ws + WS_CTL, 0, CTL_ZERO, stream);
    Args a{};
    for (int i = 0; i < 15; ++i) a.in[i] = (const float*)d_in[i];
    a.out = (float*)d_out; a.ws = (unsigned char*)d_ws;
#if ONE_LAUNCH
    a.ph_lo = 0; a.ph_hi = N_PHASES;
    void* args[] = {&a};
    hipError_t e = hipLaunchCooperativeKernel((const void*)fwd_kernel, dim3(grid), dim3(512), args, LDS_BYTES, stream);
    if (e != hipSuccess) fprintf(stderr, "cooperative launch failed: %s (grid %d)\n", hipGetErrorString(e), grid);
#else
    for (int ph = 0; ph < N_PHASES; ++ph) { a.ph_lo = ph; a.ph_hi = ph + 1; hipLaunchKernelGGL(fwd_kernel, dim3(grid), dim3(512), LDS_BYTES, stream, a); }
#endif
}
```

```cpp
#include <hip/hip_runtime.h>
#include <hip/hip_cooperative_groups.h>
#include <cstdio>
#include <cstdint>
namespace cg = cooperative_groups;

#ifndef ONE_LAUNCH
#define ONE_LAUNCH 1
#endif

#define LAS __attribute__((address_space(3)))
typedef unsigned short bf16_t;
typedef short bf16x8 __attribute__((ext_vector_type(8)));
typedef short s16x4 __attribute__((ext_vector_type(4)));
typedef float f32x4 __attribute__((ext_vector_type(4)));
typedef float f32x2 __attribute__((ext_vector_type(2)));
typedef float f32x16 __attribute__((ext_vector_type(16)));
typedef unsigned u32x4 __attribute__((ext_vector_type(4)));
typedef unsigned u32x2 __attribute__((ext_vector_type(2)));

constexpr int DM = 1024, NB = 4, SEQ = 8192, NMETA = 16, DFF = 2816;
constexpr int NREAL = NB * SEQ;
constexpr int MROW = NREAL;
constexpr int MP = 33024;
constexpr int DQKV = 3072, NATT = 3328;
constexpr float EPS = 1e-6f;
constexpr float LOG2E = 1.4426950408889634f;
constexpr float QSCALE = 0.125f * LOG2E;
constexpr float THR2 = -152.0f;

constexpr size_t MiB = 1u << 20;
constexpr size_t WS_CTL = 0;
constexpr size_t WS_WIN = 1 * MiB;
constexpr size_t WIN_BYTES = (size_t)5632 * 1024 * 2;
constexpr size_t WS_WOUT = WS_WIN + 4 * WIN_BYTES;
constexpr size_t WOUT_BYTES = (size_t)1024 * 2816 * 2;
constexpr size_t WS_WAI = WS_WOUT + 4 * WOUT_BYTES;
constexpr size_t WS_WAO = WS_WAI + (size_t)NATT * 1024 * 2;
constexpr size_t WS_WPOOL = WS_WAO + (size_t)1024 * 1024 * 2;
constexpr size_t WS_HB = WS_WPOOL + (size_t)1024 * 256 * 2;
constexpr size_t WS_SSQ = WS_HB + (size_t)MP * 1024 * 2;
constexpr size_t WS_HMETA = WS_SSQ + (size_t)MP * 16 * 4;
constexpr size_t WS_OB = WS_HMETA + (size_t)256 * 1024 * 4;
constexpr size_t WS_LOGF = WS_OB + (size_t)MP * 1024 * 2;
constexpr size_t WS_C2 = WS_LOGF + (size_t)MP * 8 * 4;
constexpr size_t WS_C2M = WS_C2 + (size_t)32 * 8192 * 4;
constexpr size_t WS_SSQM = WS_C2M + 4096;
constexpr size_t WS_BIG = WS_SSQM + 4096;
constexpr size_t WS_END = WS_BIG + (size_t)MP * DQKV * 2;

constexpr int LDS_BYTES = 147456;
constexpr int LDS_MISC = LDS_BYTES - 64;
constexpr size_t CTL_BAR = 16384, CTL_ZERO = 65536;

namespace pg8 {
constexpr int BM = 256, BK = 64, HALF = 128, HTB = HALF * BK * 2, STAGE_BYTES = 8 * HTB, NXCD = 8, WGM = 4;
__host__ __device__ __forceinline__ int lds_byte(int r, int c) { const int st = (r >> 4) * 2 + (c >> 5), rr = r & 15, cc = c & 31, ob = rr * 64 + cc * 2; return st * 1024 + (ob ^ (((ob >> 9) & 1) << 5)); }
__host__ __device__ __forceinline__ void stage_rc(int b, int& R, int& C) { const int st = b / 1024, sb = b % 1024, swz = sb ^ (((sb >> 9) & 1) << 5); R = (st >> 1) * 16 + swz / 64; C = (st & 1) * 32 + (swz % 64) / 2; }
__host__ __device__ __forceinline__ int perm32(int rho) { const int n = rho >> 4, i = rho & 15; return 8 * (i >> 2) + 4 * n + (i & 3); }

struct Unit { int pm, pn; };
struct Gemm { const bf16_t* A; const bf16_t* Bt; int M, N, K, lda, ldb, acol; };

struct StaticOrder {
    int nM, nN, nwg, G, c;
    __device__ void init(int M, int N, int G_, int c_) { nM = M / BM; nN = N / BM; nwg = nM * nN; G = G_; c = c_; }
    __device__ bool next(int i, Unit& u) const {
        const long L = (long)i * G + c; if (L >= nwg) return false;
        int wgid = (int)L; { const int q = nwg / NXCD, r = nwg % NXCD, xcd = wgid % NXCD, off = wgid / NXCD; wgid = (xcd < r ? xcd * (q + 1) : r * (q + 1) + (xcd - r) * q) + off; }
        const int nig = WGM * nN, gid = wgid / nig, fm = gid * WGM, gsz = (nM - fm) < WGM ? (nM - fm) : WGM;
        u.pm = fm + ((wgid % nig) % gsz); u.pn = (wgid % nig) / gsz; return true;
    }
};

typedef __bf16 bf16x2_t __attribute__((ext_vector_type(2)));
__device__ __forceinline__ unsigned cvt_pk_bf16(float lo, float hi) { const f32x2 v = {lo, hi}; const bf16x2_t b = __builtin_convertvector(v, bf16x2_t); return __builtin_bit_cast(unsigned, b); }

__device__ __forceinline__ float row_rstd(const float* ssq, int row) {
    const f32x4* p = (const f32x4*)(ssq + (size_t)row * 16);
    const f32x4 a = p[0], b = p[1], c = p[2], d = p[3];
    const float s = ((a[0] + a[1]) + (a[2] + a[3])) + ((b[0] + b[1]) + (b[2] + b[3])) + ((c[0] + c[1]) + (c[2] + c[3])) + ((d[0] + d[1]) + (d[2] + d[3]));
    return 1.0f / sqrtf(s * (1.0f / 1024.0f) + EPS);
}
__device__ __forceinline__ float fq_sum(float v) {
    auto a = __builtin_amdgcn_permlane16_swap(__float_as_uint(v), __float_as_uint(v), false, false);
    v = __uint_as_float(a[0]) + __uint_as_float(a[1]);
    auto b = __builtin_amdgcn_permlane32_swap(__float_as_uint(v), __float_as_uint(v), false, false);
    return __uint_as_float(b[0]) + __uint_as_float(b[1]);
}
__device__ __forceinline__ float row_rstd4(const float* ssq, int row, int fq) {
    const f32x4 a = *(const f32x4*)(ssq + (size_t)row * 16 + 4 * fq);
    float s = (a[0] + a[1]) + (a[2] + a[3]);
    s = fq_sum(s);
    return __builtin_amdgcn_rsqf(s * (1.0f / 1024.0f) + EPS);
}
__device__ __forceinline__ float silu_mul2(float gp, float upp) { return gp * upp * __builtin_amdgcn_rcpf(1.0f + __builtin_amdgcn_exp2f(-gp)); }
__device__ __forceinline__ float silu_mul(float g, float u) { return g * __builtin_amdgcn_rcpf(1.0f + __builtin_amdgcn_exp2f(-g * LOG2E)) * u; }

struct EpiSwiGLU {
    static constexpr bool PERM = true;
    bf16_t* Hd; const float* ssq;
    static __device__ __forceinline__ float act(float g, float u, float rs) {
        float t = g * rs; asm("" : "+v"(t));
        float uu = u * rs; asm("" : "+v"(uu));
        float d = 1.0f + __builtin_amdgcn_exp2f(-t); asm("" : "+v"(d));
        float tu = t * uu; asm("" : "+v"(tu));
        return tu * __builtin_amdgcn_rcpf(d);
    }
    __device__ __forceinline__ void operator()(const f32x4 (&acc)[2][2][4][2], const Unit& u, int wr, int wc, int fr, int fq) const {
        float rsv[2][4];
#pragma unroll
        for (int ai = 0; ai < 2; ++ai)
#pragma unroll
            for (int m = 0; m < 4; ++m) rsv[ai][m] = row_rstd4(ssq, u.pm * BM + ai * HALF + wr * 64 + m * 16 + fr, fq);
#pragma unroll
        for (int ai = 0; ai < 2; ++ai)
#pragma unroll
            for (int m = 0; m < 4; ++m) {
                const int row = u.pm * BM + ai * HALF + wr * 64 + m * 16 + fr;
                const float rs = rsv[ai][m];
                u32x4 w;
                w.x = cvt_pk_bf16(act(acc[ai][0][m][0][0], acc[ai][1][m][0][0], rs), act(acc[ai][0][m][0][1], acc[ai][1][m][0][1], rs));
                w.y = cvt_pk_bf16(act(acc[ai][0][m][0][2], acc[ai][1][m][0][2], rs), act(acc[ai][0][m][0][3], acc[ai][1][m][0][3], rs));
                w.z = cvt_pk_bf16(act(acc[ai][0][m][1][0], acc[ai][1][m][1][0], rs), act(acc[ai][0][m][1][1], acc[ai][1][m][1][1], rs));
                w.w = cvt_pk_bf16(act(acc[ai][0][m][1][2], acc[ai][1][m][1][2], rs), act(acc[ai][0][m][1][3], acc[ai][1][m][1][3], rs));
                __builtin_nontemporal_store(w, (u32x4*)(Hd + (size_t)row * DFF + u.pn * 128 + wc * 32 + 8 * fq));
            }
    }
};
struct EpiResid {
    static constexpr bool PERM = true;
    float* outf; bf16_t* hb; float* ssq; const float* colscale; float alpha; int last;
    __device__ __forceinline__ void operator()(const f32x4 (&acc)[2][2][4][2], const Unit& u, int wr, int wc, int fr, int fq) const {
        f32x4 sc[2][2];
#pragma unroll
        for (int bj = 0; bj < 2; ++bj)
#pragma unroll
            for (int n = 0; n < 2; ++n) { const int c = u.pn * BM + bj * HALF + wc * 32 + 8 * fq + 4 * n;
                sc[bj][n] = colscale ? *(const f32x4*)(colscale + c) * alpha : (f32x4){alpha, alpha, alpha, alpha}; }
#pragma unroll
        for (int ai = 0; ai < 2; ++ai) {
            u32x4 hpre[4][2];
#pragma unroll
            for (int m = 0; m < 4; ++m)
#pragma unroll
                for (int bj = 0; bj < 2; ++bj) hpre[m][bj] = *(const u32x4*)(hb + (size_t)(u.pm * BM + ai * HALF + wr * 64 + m * 16 + fr) * DM + u.pn * BM + bj * HALF + wc * 32 + 8 * fq);
#pragma unroll
            for (int m = 0; m < 4; ++m) {
                const int row = u.pm * BM + ai * HALF + wr * 64 + m * 16 + fr;
                float s = 0.f;
#pragma unroll
                for (int bj = 0; bj < 2; ++bj) { const int c0 = u.pn * BM + bj * HALF + wc * 32 + 8 * fq;
                    const u32x4 hv = hpre[m][bj];
                    f32x4 h0 = (f32x4){__builtin_bit_cast(float, hv.x << 16), __builtin_bit_cast(float, hv.x & 0xffff0000u), __builtin_bit_cast(float, hv.y << 16), __builtin_bit_cast(float, hv.y & 0xffff0000u)};
                    f32x4 h1 = (f32x4){__builtin_bit_cast(float, hv.z << 16), __builtin_bit_cast(float, hv.z & 0xffff0000u), __builtin_bit_cast(float, hv.w << 16), __builtin_bit_cast(float, hv.w & 0xffff0000u)};
                    h0 = h0 + acc[ai][bj][m][0] * sc[bj][0]; h1 = h1 + acc[ai][bj][m][1] * sc[bj][1];
                    s += ((h0[0] * h0[0] + h0[1] * h0[1]) + (h0[2] * h0[2] + h0[3] * h0[3])) + ((h1[0] * h1[0] + h1[1] * h1[1]) + (h1[2] * h1[2] + h1[3] * h1[3]));
                    if (last) { *(f32x4*)(outf + (size_t)row * DM + c0) = h0; *(f32x4*)(outf + (size_t)row * DM + c0 + 4) = h1; }
                    else { u32x4 w; w.x = cvt_pk_bf16(h0[0], h0[1]); w.y = cvt_pk_bf16(h0[2], h0[3]); w.z = cvt_pk_bf16(h1[0], h1[1]); w.w = cvt_pk_bf16(h1[2], h1[3]); *(u32x4*)(hb + (size_t)row * DM + c0) = w; } }
                s = fq_sum(s);
                if (!last && fq == 0) ssq[(size_t)row * 16 + u.pn * 4 + wc] = s;
            }
        }
    }
};
struct EpiQKV {
    static constexpr bool PERM = true;
    bf16_t* qkv; float* logf; const float* ssq; const float* bf;
    __device__ __forceinline__ void operator()(const f32x4 (&acc)[2][2][4][2], const Unit& u, int wr, int wc, int fr, int fq) const {
        float rsv[2][4];
#pragma unroll
        for (int ai = 0; ai < 2; ++ai)
#pragma unroll
            for (int m = 0; m < 4; ++m) rsv[ai][m] = row_rstd4(ssq, u.pm * BM + ai * HALF + wr * 64 + m * 16 + fr, fq);
#pragma unroll
        for (int ai = 0; ai < 2; ++ai)
#pragma unroll
            for (int m = 0; m < 4; ++m) {
                const int row = u.pm * BM + ai * HALF + wr * 64 + m * 16 + fr;
                const float rs = rsv[ai][m];
                if (u.pn < 12) {
#pragma unroll
                    for (int bj = 0; bj < 2; ++bj) { const int c0 = u.pn * BM + bj * HALF + wc * 32 + 8 * fq;
                        const float s = ((c0 < 512) || (c0 >= 1536 && c0 < 2048)) ? rs * QSCALE : rs;
                        const f32x4 v0 = acc[ai][bj][m][0] * s, v1 = acc[ai][bj][m][1] * s; u32x4 w;
                        w.x = cvt_pk_bf16(v0[0], v0[1]); w.y = cvt_pk_bf16(v0[2], v0[3]); w.z = cvt_pk_bf16(v1[0], v1[1]); w.w = cvt_pk_bf16(v1[2], v1[3]);
                        __builtin_nontemporal_store(w, (u32x4*)(qkv + (size_t)row * DQKV + c0)); }
                } else if (wc == 0 && fq == 0) {
                    f32x4 o[2];
#pragma unroll
                    for (int n = 0; n < 2; ++n) { const f32x4 x = acc[ai][0][m][n] * rs + *(const f32x4*)(bf + 4 * n);
#pragma unroll
                        for (int i = 0; i < 4; ++i) { const float xv = x[i]; o[n][i] = fminf(xv, 0.f) * LOG2E - __builtin_amdgcn_logf(1.0f + __builtin_amdgcn_exp2f(-fabsf(xv) * LOG2E)); } }
                    *(f32x4*)(logf + (size_t)row * 8) = o[0]; *(f32x4*)(logf + (size_t)row * 8 + 4) = o[1];
                }
            }
    }
};

template <class Epi, class Sched>
__device__ __forceinline__ void gemm_phase(LAS unsigned char* lds, const Gemm g, const Sched& S, const Epi& E) {
    const int tid = threadIdx.x, wid = __builtin_amdgcn_readfirstlane(tid >> 6), lane = tid & 63, wr = wid >> 2, wc = wid & 3, fr = lane & 15, fq = lane >> 4;
    const int K = g.K, nt = K / BK;
    unsigned voffA[2], voffB[2];
#pragma unroll
    for (int i = 0; i < 2; ++i) { int R, C; stage_rc(tid * 16 + i * 8192, R, C); const int Rb = Epi::PERM ? ((R & ~31) + perm32(R & 31)) : R;
        voffA[i] = (unsigned)(R * g.lda + C) * 2u; voffB[i] = (unsigned)(Rb * g.ldb + C) * 2u; }
    const size_t kstep = (size_t)(BK * 2);
    const size_t hstepA = (size_t)HALF * g.lda * 2, hstepB = (size_t)HALF * g.ldb * 2;
    const size_t tstepA = 2 * hstepA, tstepB = 2 * hstepB;
    const unsigned ldsw = (unsigned)wid * 1024u;
    const int aoff = lds_byte(wr * 64 + fr, fq * 8), boff = lds_byte(wc * 32 + fr, fq * 8);
#define PG8_SA(b, h) (((b) * 2 + (h)) * HTB)
#define PG8_SB(b, h) ((4 + (b) * 2 + (h)) * HTB)
#define PG8_STAGE(bufoff, gbase, voff) do { _Pragma("unroll") for (int _i = 0; _i < 2; ++_i) \
        __builtin_amdgcn_global_load_lds((const unsigned*)((const char*)(gbase) + (voff)[_i]), (LAS unsigned*)(lds + (bufoff) + ldsw + _i * 8192), 16, 0, 0); } while (0)
#define PG8_LDA(dst, b, h) do { _Pragma("unroll") for (int m = 0; m < 4; ++m) _Pragma("unroll") for (int k = 0; k < 2; ++k) dst[m][k] = *(const LAS bf16x8*)(lds + PG8_SA(b, h) + aoff + m * 2048 + k * 1024); } while (0)
#define PG8_LDB(dst, b, h) do { _Pragma("unroll") for (int n = 0; n < 2; ++n) _Pragma("unroll") for (int k = 0; k < 2; ++k) dst[n][k] = *(const LAS bf16x8*)(lds + PG8_SB(b, h) + boff + n * 2048 + k * 1024); } while (0)
#define PG8_MMA(ai, bj, At, Bt) do { __builtin_amdgcn_s_setprio(1); _Pragma("unroll") for (int m = 0; m < 4; ++m) _Pragma("unroll") for (int n = 0; n < 2; ++n) _Pragma("unroll") for (int k = 0; k < 2; ++k) \
        acc[ai][bj][m][n] = __builtin_amdgcn_mfma_f32_16x16x32_bf16(Bt[n][k], At[m][k], acc[ai][bj][m][n], 0, 0, 0); __builtin_amdgcn_s_setprio(0); } while (0)
#define PG8_WAIT_V(n) asm volatile("s_waitcnt vmcnt(" #n ")" ::: "memory")
#define PG8_WAIT_L(n) asm volatile("s_waitcnt lgkmcnt(" #n ")" ::: "memory")
#define PG8_BAR __builtin_amdgcn_s_barrier()
#define PG8_SCHED __builtin_amdgcn_sched_barrier(0)
    Unit cur, nxt; int ui = 0;
    if (!S.next(0, cur)) return;
    f32x4 acc[2][2][4][2];
#pragma unroll
    for (int a = 0; a < 2; ++a)
#pragma unroll
        for (int b = 0; b < 2; ++b)
#pragma unroll
            for (int m = 0; m < 4; ++m)
#pragma unroll
                for (int n = 0; n < 2; ++n) acc[a][b][m][n] = (f32x4){0.f, 0.f, 0.f, 0.f};
    bf16x8 At[4][2], B0[2][2], B1[2][2];
    const char* cA = (const char*)g.A + (size_t)cur.pm * tstepA + (size_t)cur.pn * g.acol * 2; const char* cB = (const char*)g.Bt + (size_t)cur.pn * tstepB;
    PG8_STAGE(PG8_SB(0, 0), cB, voffB); PG8_STAGE(PG8_SB(0, 1), cB + hstepB, voffB); PG8_STAGE(PG8_SA(0, 0), cA, voffA); PG8_STAGE(PG8_SA(0, 1), cA + hstepA, voffA);
    if (wr == 1) PG8_BAR;
    PG8_WAIT_V(2); PG8_BAR;
    PG8_STAGE(PG8_SB(1, 0), cB + kstep, voffB); PG8_STAGE(PG8_SA(1, 0), cA + kstep, voffA); PG8_STAGE(PG8_SB(1, 1), cB + hstepB + kstep, voffB);
    PG8_WAIT_V(6); PG8_BAR;
    for (;;) {
        const bool has_next = S.next(ui + 1, nxt);
        const char* nA = has_next ? (const char*)g.A + (size_t)nxt.pm * tstepA + (size_t)nxt.pn * g.acol * 2 : cA; const char* nB = has_next ? (const char*)g.Bt + (size_t)nxt.pn * tstepB : cB;
        for (int t = 0; t < nt; t += 2) {
            const bool last = (t == nt - 2);
            const char* a1 = cA + (size_t)(t + 1) * kstep;
            const char* a2 = last ? nA : cA + (size_t)(t + 2) * kstep; const char* b2 = last ? nB : cB + (size_t)(t + 2) * kstep;
            const char* a3 = a2 + kstep; const char* b3 = b2 + kstep;
            PG8_LDB(B0, 0, 0); PG8_LDB(B1, 0, 1); PG8_SCHED; PG8_LDA(At, 0, 0); PG8_STAGE(PG8_SA(1, 1), a1 + hstepA, voffA);
            PG8_WAIT_V(8); PG8_WAIT_L(0); PG8_BAR; PG8_MMA(0, 0, At, B0); PG8_MMA(0, 1, At, B1); PG8_BAR; PG8_SCHED;
            PG8_LDA(At, 0, 1); PG8_STAGE(PG8_SB(0, 0), b2, voffB); PG8_STAGE(PG8_SB(0, 1), b2 + hstepB, voffB); PG8_STAGE(PG8_SA(0, 0), a2, voffA);
            PG8_WAIT_V(8); PG8_WAIT_L(0); PG8_BAR; PG8_MMA(1, 0, At, B0); PG8_MMA(1, 1, At, B1); PG8_BAR; PG8_SCHED;
            PG8_LDB(B0, 1, 0); PG8_LDB(B1, 1, 1); PG8_SCHED; PG8_LDA(At, 1, 0); PG8_STAGE(PG8_SA(0, 1), a2 + hstepA, voffA);
            PG8_WAIT_V(8); PG8_WAIT_L(0); PG8_BAR; PG8_MMA(0, 0, At, B0); PG8_MMA(0, 1, At, B1); PG8_BAR; PG8_SCHED;
            PG8_LDA(At, 1, 1); PG8_STAGE(PG8_SB(1, 0), b3, voffB); PG8_STAGE(PG8_SB(1, 1), b3 + hstepB, voffB); PG8_STAGE(PG8_SA(1, 0), a3, voffA);
            PG8_WAIT_V(8); PG8_WAIT_L(0); PG8_BAR; PG8_MMA(1, 0, At, B0); PG8_MMA(1, 1, At, B1); PG8_BAR; PG8_SCHED;
        }
        if (wr == 0) PG8_BAR;
        E(acc, cur, wr, wc, fr, fq);
        if (!has_next) break;
#pragma unroll
        for (int a = 0; a < 2; ++a)
#pragma unroll
            for (int b = 0; b < 2; ++b)
#pragma unroll
                for (int m = 0; m < 4; ++m)
#pragma unroll
                    for (int n = 0; n < 2; ++n) acc[a][b][m][n] = (f32x4){0.f, 0.f, 0.f, 0.f};
        cur = nxt; cA = nA; cB = nB; ++ui;
        if (wr == 1) PG8_BAR;
    }
    PG8_WAIT_V(0);
    PG8_BAR;
#undef PG8_SA
#undef PG8_SB
#undef PG8_STAGE
#undef PG8_LDA
#undef PG8_LDB
#undef PG8_MMA
#undef PG8_WAIT_V
#undef PG8_WAIT_L
#undef PG8_BAR
#undef PG8_SCHED
}
}

__device__ __forceinline__ unsigned f2bf(float f) { unsigned u = __builtin_bit_cast(unsigned, f); return (u + 0x7fffu + ((u >> 16) & 1u)) >> 16; }
__device__ __forceinline__ unsigned pk2(float lo, float hi) { return f2bf(lo) | (f2bf(hi) << 16); }
__device__ __forceinline__ float bf2f(unsigned short v) { return __builtin_bit_cast(float, (unsigned)v << 16); }
__device__ __forceinline__ float wave_sum(float v) {
#pragma unroll
    for (int o = 1; o < 64; o <<= 1) v += __shfl_xor(v, o);
    return v;
}
#define LDS_WAIT() asm volatile("s_waitcnt lgkmcnt(0)" ::: "memory")

struct Args {
    const float* in[15];
    float* out; unsigned char* ws;
    int ph_lo, ph_hi;
};

__device__ __forceinline__ void tr_item(const float* W, int N, int nvalid, int sc0, int k0, const float* g, bf16_t* WT, int K, int n0, LAS float* scr, int lane, float cm = 1.0f) {
    const int nq = lane & 7, kr = lane >> 3;
#pragma unroll
    for (int i = 0; i < 8; ++i) { const int kk = i * 8 + kr, col = sc0 + 4 * nq;
        f32x4 v = (f32x4){0.f, 0.f, 0.f, 0.f};
        if (col + 3 < nvalid) v = *(const f32x4*)(W + (size_t)(k0 + kk) * N + col);
        if (g) v = v * (g[k0 + kk] * cm);
        LAS float* s = scr + kk * 33 + 4 * nq; s[0] = v[0]; s[1] = v[1]; s[2] = v[2]; s[3] = v[3]; }
    LDS_WAIT();
    const int c = lane & 7;
#pragma unroll
    for (int j = 0; j < 4; ++j) { const int n = (lane >> 3) + 8 * j; const LAS float* s = scr + (8 * c) * 33 + n;
        u32x4 o; o.x = pk2(s[0 * 33], s[1 * 33]); o.y = pk2(s[2 * 33], s[3 * 33]); o.z = pk2(s[4 * 33], s[5 * 33]); o.w = pk2(s[6 * 33], s[7 * 33]);
        *(u32x4*)(WT + (size_t)(n0 + n) * K + k0 + 8 * c) = o; }
    LDS_WAIT();
}

__device__ __forceinline__ void p0_prologue(const Args& a, LAS unsigned char* lds, int G) {
    const int tid = threadIdx.x, lane = tid & 63, wave = __builtin_amdgcn_readfirstlane(tid >> 6);
    LAS float* scr = (LAS float*)(lds + wave * 16384);
    const int gw = blockIdx.x * 8 + wave, NGW = G * 8;
    unsigned char* ws = a.ws;
    constexpr int I_IN = 16 * 176, I_OUT = 44 * 32, I_AI = 16 * 104, I_AO = 16 * 32, I_PL = 4 * 8;
    constexpr int NITEMS = 4 * I_IN + 4 * I_OUT + I_AI + I_AO + 4 * I_PL;
    for (int it = gw; it < NITEMS; it += NGW) {
        int r = it;
        if (r < 4 * I_IN) { const int mI = r / I_IN, q = r % I_IN, kb = q / 176, nb = q % 176, layer = mI >> 1, which = mI & 1;
            const float* W = (which ? a.in[7] : a.in[3]) + (size_t)layer * 1024 * 5632; const float* g = (which ? a.in[6] : a.in[2]) + layer * 1024;
            const int n0 = nb * 32, tile = n0 >> 8, within = n0 & 255, sc0 = within < 128 ? tile * 128 + within : DFF + tile * 128 + (within - 128);
            tr_item(W, 5632, 5632, sc0, kb * 64, g, (bf16_t*)(ws + WS_WIN + mI * WIN_BYTES), 1024, n0, scr, lane, within < 128 ? LOG2E : 1.0f / LOG2E); continue; }
        r -= 4 * I_IN;
        if (r < 4 * I_OUT) { const int mI = r / I_OUT, q = r % I_OUT, kb = q / 32, nb = q % 32, layer = mI >> 1, which = mI & 1;
            const float* W = (which ? a.in[8] : a.in[4]) + (size_t)layer * DFF * 1024;
            tr_item(W, 1024, 1024, nb * 32, kb * 64, nullptr, (bf16_t*)(ws + WS_WOUT + mI * WOUT_BYTES), DFF, nb * 32, scr, lane); continue; }
        r -= 4 * I_OUT;
        if (r < I_AI) { const int kb = r / 104, nb = r % 104;
            tr_item(a.in[9], 3080, 3080, nb * 32, kb * 64, a.in[5], (bf16_t*)(ws + WS_WAI), 1024, nb * 32, scr, lane); continue; }
        r -= I_AI;
        if (r < I_AO) { const int kb = r / 32, nb = r % 32;
            tr_item(a.in[11], 1024, 1024, nb * 32, kb * 64, nullptr, (bf16_t*)(ws + WS_WAO), 1024, nb * 32, scr, lane); continue; }
        r -= I_AO;
        { const int gI = r / I_PL, q = r % I_PL, kb = q / 8, nb = q % 8;
            tr_item(a.in[12] + (size_t)gI * 256 * 256, 256, 256, nb * 32, kb * 64, nullptr, (bf16_t*)(ws + WS_WPOOL) + (size_t)gI * 256 * 256, 256, nb * 32, scr, lane); }
    }
    float* hmeta = (float*)(ws + WS_HMETA); bf16_t* hb = (bf16_t*)(ws + WS_HB); float* ssq = (float*)(ws + WS_SSQ); bf16_t* ob = (bf16_t*)(ws + WS_OB);
    for (int row0 = gw; row0 < MP; row0 += 2 * NGW) {
        f32x4 v[2][4];
#pragma unroll
        for (int q = 0; q < 2; ++q) { const int row = row0 + q * NGW;
            const float* src = row < NREAL ? a.in[0] + (size_t)row * DM : (row < NREAL + NMETA ? a.in[1] + (size_t)(row - NREAL) * DM : nullptr);
#pragma unroll
            for (int j = 0; j < 4; ++j) v[q][j] = src ? ((const f32x4*)src)[64 * j + lane] : (f32x4){0.f, 0.f, 0.f, 0.f}; }
#pragma unroll
        for (int q = 0; q < 2; ++q) { const int row = row0 + q * NGW; if (row >= MP) break;
            float s = 0.f;
#pragma unroll
            for (int j = 0; j < 4; ++j) s += (v[q][j][0] * v[q][j][0] + v[q][j][1] * v[q][j][1]) + (v[q][j][2] * v[q][j][2] + v[q][j][3] * v[q][j][3]);
            s = wave_sum(s);
            float* hd = row < NREAL ? nullptr : hmeta + (size_t)(row - NREAL) * DM;
#pragma unroll
            for (int j = 0; j < 4; ++j) { if (hd) ((f32x4*)hd)[64 * j + lane] = v[q][j];
                u32x2 w; w.x = pk2(v[q][j][0], v[q][j][1]); w.y = pk2(v[q][j][2], v[q][j][3]); ((u32x2*)(hb + (size_t)row * DM))[64 * j + lane] = w;
                if (row >= NREAL + NMETA) ((u32x2*)(ob + (size_t)row * DM))[64 * j + lane] = (u32x2){0u, 0u}; }
            if (lane < 16) ssq[(size_t)row * 16 + lane] = lane == 0 ? s : 0.f;
            if (row >= MROW && row < MROW + NMETA) ((float*)(ws + WS_SSQM))[(row - MROW) * 64 + lane] = lane == 0 ? s : 0.f;
            if (row >= MROW + NMETA && row < MROW + 64) { u32x4* qp = (u32x4*)((bf16_t*)(ws + WS_BIG) + (size_t)row * DQKV); for (int j = lane; j < DQKV / 8; j += 64) qp[j] = (u32x4){0u, 0u, 0u, 0u}; }
        }
    }
}

namespace mt {
__device__ __forceinline__ float rstd_meta(const float* ssqm, int row) {
    const f32x4* p = (const f32x4*)(ssqm + row * 64); float s = 0.f;
#pragma unroll
    for (int i = 0; i < 16; ++i) { const f32x4 a = p[i]; s += (a[0] + a[1]) + (a[2] + a[3]); }
    return 1.0f / sqrtf(s * (1.0f / 1024.0f) + EPS);
}
template <int K>
__device__ __forceinline__ f32x4 dot(const bf16_t* A, int lda, const bf16_t* Bt, int n0, int wave, int lane) {
    const int fr = lane & 15, fq = lane >> 4; constexpr int KW = K / 8;
    const bf16_t* ap = A + (size_t)fr * lda + wave * KW + 8 * fq; const bf16_t* bp = Bt + (size_t)(n0 + fr) * K + wave * KW + 8 * fq;
    f32x4 acc = (f32x4){0.f, 0.f, 0.f, 0.f};
#pragma unroll
    for (int k = 0; k < KW; k += 32) { const bf16x8 av = *(const bf16x8*)(ap + k), bv = *(const bf16x8*)(bp + k); acc = __builtin_amdgcn_mfma_f32_16x16x32_bf16(bv, av, acc, 0, 0, 0); }
    return acc;
}
__device__ __forceinline__ f32x4 reduce8(LAS unsigned char* lds, f32x4 v, int slot, int wave, int lane) {
    LAS f32x4* red = (LAS f32x4*)lds + slot * 512;
    red[wave * 64 + lane] = v;
    __syncthreads();
    f32x4 s = red[lane];
#pragma unroll
    for (int w = 1; w < 8; ++w) s = s + red[w * 64 + lane];
    return s;
}
__device__ __forceinline__ void ffn_in(LAS unsigned char* lds, unsigned char* ws, int mI, int G) {
    const int tid = threadIdx.x, lane = tid & 63, wave = __builtin_amdgcn_readfirstlane(tid >> 6), fr = lane & 15, fq = lane >> 4;
    const bf16_t* hbm = (const bf16_t*)(ws + WS_HB) + (size_t)MROW * DM; const bf16_t* W = (const bf16_t*)(ws + WS_WIN + mI * WIN_BYTES);
    bf16_t* hid = (bf16_t*)(ws + WS_BIG) + (size_t)MROW * DFF;
    for (int jp = blockIdx.x; jp < 176; jp += G) { const int tile = jp >> 3, sub = jp & 7, ng = tile * 256 + sub * 16;
        f32x4 g = dot<1024>(hbm, DM, W, ng, wave, lane), u = dot<1024>(hbm, DM, W, ng + 128, wave, lane);
        __syncthreads();
        g = reduce8(lds, g, 0, wave, lane); u = reduce8(lds, u, 1, wave, lane);
        if (wave == 0) { const float rs = rstd_meta((const float*)(ws + WS_SSQM), fr); g = g * rs; u = u * rs;
            u32x2 w; w.x = pg8::cvt_pk_bf16(pg8::silu_mul2(g[0], u[0]), pg8::silu_mul2(g[1], u[1])); w.y = pg8::cvt_pk_bf16(pg8::silu_mul2(g[2], u[2]), pg8::silu_mul2(g[3], u[3]));
            *(u32x2*)(hid + (size_t)fr * DFF + tile * 128 + sub * 16 + 4 * fq) = w; } }
    __syncthreads();
}
template <int K>
__device__ __forceinline__ void resid(LAS unsigned char* lds, unsigned char* ws, const bf16_t* A, int lda, const bf16_t* W, float alpha, int G) {
    const int tid = threadIdx.x, lane = tid & 63, wave = __builtin_amdgcn_readfirstlane(tid >> 6), fr = lane & 15, fq = lane >> 4;
    float* hmeta = (float*)(ws + WS_HMETA); bf16_t* hbm = (bf16_t*)(ws + WS_HB) + (size_t)MROW * DM; float* ssqm = (float*)(ws + WS_SSQM);
    for (int jt = blockIdx.x; jt < 64; jt += G) {
        f32x4 acc = dot<K>(A, lda, W, 16 * jt, wave, lane);
        __syncthreads();
        acc = reduce8(lds, acc, 0, wave, lane);
        if (wave == 0) { const int c = 16 * jt + 4 * fq; float* hp = hmeta + (size_t)fr * DM + c;
            f32x4 hv = *(const f32x4*)hp; hv = hv + acc * alpha; *(f32x4*)hp = hv;
            u32x2 w; w.x = pg8::cvt_pk_bf16(hv[0], hv[1]); w.y = pg8::cvt_pk_bf16(hv[2], hv[3]); *(u32x2*)(hbm + (size_t)fr * DM + c) = w;
            float s = (hv[0] * hv[0] + hv[1] * hv[1]) + (hv[2] * hv[2] + hv[3] * hv[3]); s = pg8::fq_sum(s);
            if (fq == 0) ssqm[fr * 64 + jt] = s; } }
    __syncthreads();
}
__device__ __forceinline__ void attn_in(LAS unsigned char* lds, unsigned char* ws, const float* bf, int G) {
    const int tid = threadIdx.x, lane = tid & 63, wave = __builtin_amdgcn_readfirstlane(tid >> 6), fr = lane & 15, fq = lane >> 4;
    const bf16_t* hbm = (const bf16_t*)(ws + WS_HB) + (size_t)MROW * DM; const bf16_t* W = (const bf16_t*)(ws + WS_WAI);
    bf16_t* qkv = (bf16_t*)(ws + WS_BIG) + (size_t)MROW * DQKV; float* logf = (float*)(ws + WS_LOGF) + (size_t)MROW * 8;
    for (int jt = blockIdx.x; jt < 193; jt += G) {
        f32x4 acc = dot<1024>(hbm, DM, W, 16 * jt, wave, lane);
        __syncthreads();
        acc = reduce8(lds, acc, 0, wave, lane);
        if (wave == 0) { const float rs = rstd_meta((const float*)(ws + WS_SSQM), fr); const int c0 = 16 * jt + 4 * fq;
            if (jt < 192) { const float sc = ((c0 < 512) || (c0 >= 1536 && c0 < 2048)) ? rs * QSCALE : rs; const f32x4 v = acc * sc;
                u32x2 w; w.x = pg8::cvt_pk_bf16(v[0], v[1]); w.y = pg8::cvt_pk_bf16(v[2], v[3]); *(u32x2*)(qkv + (size_t)fr * DQKV + c0) = w; }
            else if (fq < 2) { const f32x4 x = acc * rs + *(const f32x4*)(bf + 4 * fq); f32x4 o;
#pragma unroll
                for (int i = 0; i < 4; ++i) { const float xv = x[i]; o[i] = fminf(xv, 0.f) * LOG2E - __builtin_amdgcn_logf(1.0f + __builtin_amdgcn_exp2f(-fabsf(xv) * LOG2E)); }
                *(f32x4*)(logf + (size_t)fr * 8 + 4 * fq) = o; } } }
    __syncthreads();
}
}

__device__ __forceinline__ void scan_phase(const Args& a, LAS unsigned char* lds, int G) {
    const int tid = threadIdx.x, lane = tid & 63, wave = __builtin_amdgcn_readfirstlane(tid >> 6);
    unsigned char* ws = a.ws;
    const float* logf = (const float*)(ws + WS_LOGF); float* c2 = (float*)(ws + WS_C2); float* c2m = (float*)(ws + WS_C2M);
    if (blockIdx.x < 32) {
        const int b = blockIdx.x >> 3, h = blockIdx.x & 7;
        LAS float* wtot = (LAS float*)lds;
        const float* lf = logf + ((size_t)b * SEQ + 16 * tid) * 8 + h;
        float v[16];
#pragma unroll
        for (int i = 0; i < 16; ++i) v[i] = lf[i * 8];
        float mt = 0.f;
        for (int j = 0; j < NMETA; ++j) { mt += logf[(size_t)(MROW + j) * 8 + h]; if (b == 0 && tid == 0) c2m[h * 16 + j] = mt; }
#pragma unroll
        for (int i = 1; i < 16; ++i) v[i] += v[i - 1];
        float inc = v[15];
#pragma unroll
        for (int o = 1; o < 64; o <<= 1) { const float t = __shfl_up(inc, o); if (lane >= o) inc += t; }
        if (lane == 63) wtot[wave] = inc;
        __syncthreads();
        float pre = mt + (inc - v[15]);
        for (int w = 0; w < wave; ++w) pre += wtot[w];
        f32x4* dst = (f32x4*)(c2 + ((size_t)(b * 8 + h) << 13) + 16 * tid);
#pragma unroll
        for (int i = 0; i < 4; ++i) dst[i] = (f32x4){v[4 * i] + pre, v[4 * i + 1] + pre, v[4 * i + 2] + pre, v[4 * i + 3] + pre};
    } else {
        const bf16_t* qkv = (const bf16_t*)(ws + WS_BIG);
        const int gw = (blockIdx.x - 32) * 8 + wave, NGW = (G - 32) * 8;
        float mx = 0.f;
        for (int row0 = gw; row0 < NREAL + NMETA; row0 += 4 * NGW) {
            u32x4 x0[4], x1[4];
#pragma unroll
            for (int q = 0; q < 4; ++q) { const int row = row0 + q * NGW < NREAL + NMETA ? row0 + q * NGW : row0;
                const u32x4* p = (const u32x4*)(qkv + (size_t)row * DQKV + 1536 + lane * 16); x0[q] = p[0]; x1[q] = p[1]; }
#pragma unroll
            for (int q = 0; q < 4; ++q) { float s = 0.f;
#pragma unroll
                for (int i = 0; i < 4; ++i) { const float a0 = __builtin_bit_cast(float, x0[q][i] << 16), a1 = __builtin_bit_cast(float, x0[q][i] & 0xffff0000u), b0 = __builtin_bit_cast(float, x1[q][i] << 16), b1 = __builtin_bit_cast(float, x1[q][i] & 0xffff0000u);
                    s += (a0 * a0 + a1 * a1) + (b0 * b0 + b1 * b1); }
                s += __shfl_xor(s, 1); s += __shfl_xor(s, 2);
                mx = fmaxf(mx, s); }
        }
        if ((lane & 3) == 0) atomicMax((unsigned*)(ws + WS_CTL) + (lane >> 5) * 8 + ((lane >> 2) & 7), __float_as_uint(mx));
    }
}

namespace att {
constexpr int KROW = 144, TILEB = 64 * KROW;
constexpr int L_K = 0, L_V = 4 * TILEB, L_CK = 8 * TILEB, L_WSF = L_CK + 1024, L_FLAG = L_WSF + 8 * 256;
__device__ __forceinline__ int crow(int r, int hi) { return (r & 3) + 8 * (r >> 2) + 4 * hi; }
typedef short v4i16_t __attribute__((ext_vector_type(4)));
__device__ __forceinline__ s16x4 vtr(LAS const unsigned char* p) { return __builtin_bit_cast(s16x4, __builtin_amdgcn_ds_read_tr16_b64_v4i16((LAS v4i16_t*)p)); }
__device__ __forceinline__ float swap_sum(float v) { auto rr = __builtin_amdgcn_permlane32_swap(__float_as_uint(v), __float_as_uint(v), false, false); return __uint_as_float(rr[0]) + __uint_as_float(rr[1]); }
__device__ __forceinline__ float swap_max(float v) { auto rr = __builtin_amdgcn_permlane32_swap(__float_as_uint(v), __float_as_uint(v), false, false); return fmaxf(__uint_as_float(rr[0]), __uint_as_float(rr[1])); }

template <bool FOX>
__device__ __forceinline__ void unit(LAS unsigned char* lds, const bf16_t* __restrict__ qkv, const float* __restrict__ c2, const float* __restrict__ c2m, float Bh, bf16_t* ob, int b, int h, int qblk) {
    const int tid = threadIdx.x, lane = tid & 63, r32 = lane & 31, hi = lane >> 5, w = __builtin_amdgcn_readfirstlane(tid >> 6);
    const bool meta = qblk < 0;
    const int qrow0 = meta ? MROW : b * SEQ + qblk * 256;
    const int qpos0 = meta ? 0 : NMETA + qblk * 256;
    const int NT = meta ? 0 : 4 * qblk + 4, ntile = NT + 1;
    const int qcol = (FOX ? 1536 : 0) + h * 64, kcol = qcol + 512, vcol = qcol + 1024, ocol = (FOX ? 512 : 0) + h * 64;
    const int qrow = qrow0 + 32 * w + r32, qpos = qpos0 + 32 * w + r32, wqmax = qpos0 + 32 * w + 31;
    const float* c2bh = c2 + ((size_t)(b * 8 + h) << 13);
    bf16x8 qf[4];
#pragma unroll
    for (int d0 = 0; d0 < 4; ++d0) qf[d0] = *(const bf16x8*)(qkv + (size_t)qrow * DQKV + qcol + d0 * 16 + hi * 8);
    float cfirst = 0.f;
    if (FOX) cfirst = meta ? 0.f : c2bh[qblk * 256];
    const int skey = tid >> 3, sch = tid & 7;
    LAS float* wsf = (LAS float*)(lds + L_WSF) + w * 64;
    LAS unsigned* flag = (LAS unsigned*)(lds + L_FLAG);
    u32x4 kreg0, vreg0, kreg1, vreg1; float ckreg0 = 0.f, ckreg1 = 0.f;
#define ATT_LOAD(idx, S) do { const int _j = NT - 1 - (idx); const int _r0 = (_j >= 0) ? b * SEQ + 64 * _j : MROW; \
        const bf16_t* _p = qkv + (size_t)(_r0 + skey) * DQKV + sch * 8; kreg##S = *(const u32x4*)(_p + kcol); vreg##S = *(const u32x4*)(_p + vcol); \
        if (FOX && tid < 64) ckreg##S = (_j >= 0) ? c2bh[64 * _j + tid] : c2m[h * 16 + (tid & 15)]; } while (0)
#define ATT_STORE(buf, S) do { *(LAS u32x4*)(lds + L_K + (buf) * TILEB + skey * KROW + sch * 16) = kreg##S; *(LAS u32x4*)(lds + L_V + (buf) * TILEB + skey * KROW + sch * 16) = vreg##S; \
        if (FOX && tid < 64) ((LAS float*)(lds + L_CK + (buf) * 256))[tid] = ckreg##S; } while (0)
    ATT_LOAD(0, 0); if (ntile > 1) ATT_LOAD(1, 1);
    ATT_STORE(0, 0); if (ntile > 1) ATT_STORE(1, 1);
    __syncthreads();
    f32x16 o[2]; o[0] = f32x16{}; o[1] = f32x16{};
    float R = 0.f;
    f32x16 osum = f32x16{};
    const bf16x8 ones8 = (bf16x8){16256, 16256, 16256, 16256, 16256, 16256, 16256, 16256};
    f32x16 negm = f32x16{}; asm volatile("" : "+v"(negm));
    bool started = false, wdone = false;
    const int vlane = (4 * hi + ((lane & 15) >> 2)) * KROW + (((lane >> 4) & 1) * 16 + (lane & 3) * 4) * 2;
    for (int it = 0;; ++it) {
        const int base = 2 * it, pb = (it & 1) * 2, nb = base + 2;
        bool more = nb < ntile;
        if (FOX && more && nb >= 4) { const int j1 = NT - 1 - nb; const float cl = (j1 >= 0) ? c2bh[64 * j1 + 63] : c2m[h * 16 + 15]; if (cfirst - cl + Bh < THR2) more = false; }
        const bool more1 = more && nb + 1 < ntile;
        if (more) ATT_LOAD(nb, 0);
        if (more1) ATT_LOAD(nb + 1, 1);
#pragma unroll
        for (int sub = 0; sub < 2; ++sub) {
        const int idx = base + sub, cur = pb + sub;
        if (idx >= ntile) break;
        const int j = NT - 1 - idx, tpos0 = (j >= 0) ? NMETA + 64 * j : 0, nvalid = (j >= 0) ? 64 : NMETA;
        if (tpos0 <= wqmax && !wdone && (!meta || w == 0)) {
            started = true;
            const LAS unsigned char* kb = lds + L_K + cur * TILEB + r32 * KROW + hi * 16;
            f32x16 p[2];
#pragma unroll
            for (int d0 = 0; d0 < 4; ++d0) {
                const bf16x8 k0 = *(const LAS bf16x8*)(kb + d0 * 32), k1 = *(const LAS bf16x8*)(kb + 32 * KROW + d0 * 32);
                if (d0 == 0) { p[0] = __builtin_amdgcn_mfma_f32_32x32x16_bf16(k0, qf[0], negm, 0, 0, 0); p[1] = __builtin_amdgcn_mfma_f32_32x32x16_bf16(k1, qf[0], negm, 0, 0, 0); }
                else { p[0] = __builtin_amdgcn_mfma_f32_32x32x16_bf16(k0, qf[d0], p[0], 0, 0, 0); p[1] = __builtin_amdgcn_mfma_f32_32x32x16_bf16(k1, qf[d0], p[1], 0, 0, 0); }
            }
            int lim = (FOX ? qpos - tpos0 : qpos - tpos0 - 1); lim = lim < nvalid - 1 ? lim : nvalid - 1;
            const int limh = lim - 4 * hi;
            if (FOX) {
                const LAS float* ckp = (const LAS float*)(lds + L_CK + cur * 256) + 4 * hi;
                const bool fullt = (tpos0 + 63 <= qpos0 + 32 * w) && nvalid == 64;
                float mt = -1e30f;
                if (fullt) {
#pragma unroll
                    for (int half = 0; half < 2; ++half)
#pragma unroll
                        for (int g = 0; g < 4; ++g) { const f32x4 ck = *(const LAS f32x4*)(ckp + 32 * half + 8 * g);
#pragma unroll
                            for (int i = 0; i < 4; ++i) { const int r = 4 * g + i; const float sv = p[half][r] - ck[i]; p[half][r] = sv; mt = fmaxf(mt, sv); } }
                } else {
#pragma unroll
                    for (int half = 0; half < 2; ++half)
#pragma unroll
                        for (int g = 0; g < 4; ++g) { const f32x4 ck = *(const LAS f32x4*)(ckp + 32 * half + 8 * g);
#pragma unroll
                            for (int i = 0; i < 4; ++i) { const int r = 4 * g + i; float sv = p[half][r] - ck[i]; sv = (32 * half + 8 * g + i <= limh) ? sv : -1e30f; p[half][r] = sv; mt = fmaxf(mt, sv); } }
                }
                mt = swap_max(mt);
                if (__any(mt > 6.0f)) {
                    const float dl = fmaxf(mt, 0.f); R += dl;
#pragma unroll
                    for (int half = 0; half < 2; ++half)
#pragma unroll
                        for (int r = 0; r < 16; ++r) p[half][r] -= dl;
#pragma unroll
                    for (int r = 0; r < 16; ++r) negm[r] = -R;
                    asm volatile("" : "+v"(negm));
                    const float sc = __builtin_amdgcn_exp2f(-dl);
                    if (hi == 0) wsf[r32] = sc;
                    LDS_WAIT();
#pragma unroll
                    for (int g = 0; g < 4; ++g) { const f32x4 f = *(const LAS f32x4*)(wsf + 8 * g + 4 * hi);
#pragma unroll
                        for (int i = 0; i < 4; ++i) { o[0][4 * g + i] *= f[i]; o[1][4 * g + i] *= f[i]; osum[4 * g + i] *= f[i]; } }
                }
#pragma unroll
                for (int half = 0; half < 2; ++half)
#pragma unroll
                    for (int r = 0; r < 16; ++r) p[half][r] = __builtin_amdgcn_exp2f(p[half][r]);
            } else {
                const bool fullt = (tpos0 + 64 <= qpos0 + 32 * w) && nvalid == 64;
                float T[2][4], Gs[2][4];
#define SB_PASS1(MASKED) _Pragma("unroll") for (int half = 0; half < 2; ++half) _Pragma("unroll") for (int g = 0; g < 4; ++g) { float lsv[4]; \
                    _Pragma("unroll") for (int i = 0; i < 4; ++i) { const float z = fminf(p[half][4 * g + i], 126.0f); p[half][4 * g + i] = z; \
                        const float ls = -__builtin_amdgcn_logf(1.0f + __builtin_amdgcn_exp2f(z));        \
                        lsv[i] = (!(MASKED) || (32 * half + 8 * g + i <= limh)) ? ls : 0.f; } \
                    const float s3 = lsv[3], s2 = s3 + lsv[2], s1 = s2 + lsv[1], s0 = s1 + lsv[0]; \
                    Gs[half][g] = s0; T[half][g] = swap_sum(s0); \
                    p[half][4 * g + 0] += s0; p[half][4 * g + 1] += s1; p[half][4 * g + 2] += s2; p[half][4 * g + 3] += s3; }
#define SB_PASS2(MASKED) { float suf = R; _Pragma("unroll") for (int half = 1; half >= 0; --half) _Pragma("unroll") for (int g = 3; g >= 0; --g) { \
                    const float off = suf + (hi == 0 ? T[half][g] - Gs[half][g] : 0.f); \
                    _Pragma("unroll") for (int i = 0; i < 4; ++i) { float e = __builtin_amdgcn_exp2f(p[half][4 * g + i] + off); e = (!(MASKED) || (32 * half + 8 * g + i <= limh)) ? e : 0.f; p[half][4 * g + i] = e; } \
                    suf += T[half][g]; } R = suf; }
                if (fullt) { SB_PASS1(false) SB_PASS2(false) } else { SB_PASS1(true) SB_PASS2(true) }
#undef SB_PASS1
#undef SB_PASS2
            }
            const LAS unsigned char* vb = lds + L_V + cur * TILEB + vlane;
#pragma unroll
            for (int half = 0; half < 2; ++half)
#pragma unroll
                for (int s = 0; s < 2; ++s) {
                    u32x4 pw; pw.x = pg8::cvt_pk_bf16(p[half][8 * s + 0], p[half][8 * s + 1]); pw.y = pg8::cvt_pk_bf16(p[half][8 * s + 2], p[half][8 * s + 3]);
                    pw.z = pg8::cvt_pk_bf16(p[half][8 * s + 4], p[half][8 * s + 5]); pw.w = pg8::cvt_pk_bf16(p[half][8 * s + 6], p[half][8 * s + 7]);
                    const bf16x8 pa = __builtin_bit_cast(bf16x8, pw);
                    if (FOX) osum = __builtin_amdgcn_mfma_f32_32x32x16_bf16(pa, ones8, osum, 0, 0, 0);
#pragma unroll
                    for (int d0 = 0; d0 < 2; ++d0) {
                        const s16x4 lo = vtr(vb + (32 * half + 16 * s) * KROW + d0 * 64), hh = vtr(vb + (32 * half + 16 * s + 8) * KROW + d0 * 64);
                        const bf16x8 vf = (bf16x8){lo[0], lo[1], lo[2], lo[3], hh[0], hh[1], hh[2], hh[3]};
                        o[d0] = __builtin_amdgcn_mfma_f32_32x32x16_bf16(pa, vf, o[d0], 0, 0, 0);
                    }
                }
            if (!FOX) { wdone = __all(R < THR2); }
        }
        }
        if (more) ATT_STORE((pb ^ 2), 0);
        if (more1) ATT_STORE((pb ^ 2) + 1, 1);
        const int fpar = it & 1;
        if (!FOX && lane == 0) flag[fpar * 8 + w] = (started && wdone) ? 1u : 0u;
        __syncthreads();
        if (!more) break;
        if (!FOX) { const u32x4 f0 = *(const LAS u32x4*)(flag + fpar * 8), f1 = *(const LAS u32x4*)(flag + fpar * 8 + 4);
            if ((f0.x & f0.y & f0.z & f0.w & f1.x & f1.y & f1.z & f1.w) != 0u) break; }
    }
    if (FOX) {
#pragma unroll
        for (int r = 0; r < 16; ++r) { const float inv = __builtin_amdgcn_rcpf(osum[r]); o[0][r] *= inv; o[1][r] *= inv; }
    }
    if (!meta || w == 0) {
#pragma unroll
        for (int r = 0; r < 16; ++r) { const int rr = crow(r, hi);
            if (!meta || rr < NMETA) { bf16_t* op = ob + (size_t)(qrow0 + 32 * w + rr) * DM + ocol + r32;
                op[0] = (bf16_t)f2bf(o[0][r]); op[32] = (bf16_t)f2bf(o[1][r]); } }
    }
    asm volatile("s_waitcnt lgkmcnt(0)\n\ts_barrier" ::: "memory");
#undef ATT_LOAD
#undef ATT_STORE
}
}

__device__ __forceinline__ void attn_phase(const Args& a, LAS unsigned char* lds, int G) {
    unsigned char* ws = a.ws;
    const bf16_t* qkv = (const bf16_t*)(ws + WS_BIG); const float* c2 = (const float*)(ws + WS_C2); const float* c2m = (const float*)(ws + WS_C2M);
    const float* ctl = (const float*)(ws + WS_CTL); bf16_t* ob = (bf16_t*)(ws + WS_OB);
    unsigned* ready = (unsigned*)(ws + WS_CTL) + 64;
    scan_phase(a, lds, G);
    asm volatile("s_waitcnt vmcnt(0)" ::: "memory");
    __syncthreads();
    if (threadIdx.x == 0) { __builtin_amdgcn_fence(__ATOMIC_RELEASE, "agent"); asm volatile("s_waitcnt vmcnt(0)" ::: "memory"); __hip_atomic_fetch_add(ready, 1u, __ATOMIC_RELAXED, __HIP_MEMORY_SCOPE_AGENT); }
    const bool short_cu = (blockIdx.x & 31) == 0;
    for (int i = 0; i * G < 1024; ++i) { const int id = i * G + blockIdx.x; if (id >= 1024) break;
        const int qblk = id & 31, bh = id >> 5; att::unit<false>(lds, qkv, c2, c2m, 0.f, ob, bh >> 3, bh & 7, qblk); }
    if (short_cu && (blockIdx.x >> 5) < 8) att::unit<false>(lds, qkv, c2, c2m, 0.f, ob, 0, blockIdx.x >> 5, -1);
    if (threadIdx.x == 0) { unsigned sp = 0u;
        while (__hip_atomic_load(ready, __ATOMIC_RELAXED, __HIP_MEMORY_SCOPE_AGENT) < (unsigned)G) { __builtin_amdgcn_s_sleep(2); if (++sp > (1u << 22)) break; }
        __builtin_amdgcn_fence(__ATOMIC_ACQUIRE, "agent"); asm volatile("s_waitcnt vmcnt(0)" ::: "memory"); }
    __syncthreads();
    for (int i = 0; i * G < 1024; ++i) { const int id = i * G + blockIdx.x; if (id >= 1024) break;
        const int qblk = id & 31, bh = id >> 5, h = bh & 7; const float Bh = 2.002f * sqrtf(ctl[h] * ctl[8 + h]);
        att::unit<true>(lds, qkv, c2, c2m, Bh, ob, bh >> 3, h, qblk); }
    if (short_cu && (blockIdx.x >> 5) < 8) att::unit<true>(lds, qkv, c2, c2m, 0.f, ob, 0, blockIdx.x >> 5, -1);
}

template <int W>
__device__ __forceinline__ void pool_rows(const bf16_t* __restrict__ hbp, const float* __restrict__ hmeta, bf16_t* __restrict__ pb, const LAS float* rs, f32x4 gv, int b, int start, int rs0, int cidx) {
    constexpr int K0 = 16 - W;
    u32x2 raw[47];
#pragma unroll
    for (int k = K0; k < 47; ++k) { const int pos = start - 15 + k;
        if (pos < NMETA) { const f32x4 v = *(const f32x4*)(hmeta + (size_t)pos * DM + 4 * cidx); raw[k].x = pk2(v[0], v[1]); raw[k].y = pk2(v[2], v[3]); }
        else raw[k] = *(const u32x2*)(hbp + (size_t)(b * SEQ + pos - NMETA) * DM + 4 * cidx); }
#define POOL_UK(k) ((f32x4){__builtin_bit_cast(float, raw[k].x << 16), __builtin_bit_cast(float, raw[k].x & 0xffff0000u), __builtin_bit_cast(float, raw[k].y << 16), __builtin_bit_cast(float, raw[k].y & 0xffff0000u)} * gv * rs[rs0 + (k)])
    f32x4 S = (f32x4){0.f, 0.f, 0.f, 0.f};
#pragma unroll
    for (int i = 1; i < W; ++i) S = S + POOL_UK(15 - i);
    constexpr float invw = 1.0f / (float)W;
#pragma unroll
    for (int r = 0; r < 32; ++r) {
        const f32x4 un = POOL_UK(15 + r); S = S + un;
        const f32x4 o = S * invw - un;
        u32x2 pk; pk.x = pk2(o[0], o[1]); pk.y = pk2(o[2], o[3]);
        *(u32x2*)(pb + (size_t)(b * SEQ + start + r - NMETA) * DM + 4 * cidx) = pk;
        S = S - POOL_UK(15 + r - W + 1); }
#undef POOL_UK
}
__device__ __forceinline__ void pool_phase(const Args& a, LAS unsigned char* lds, int G) {
    unsigned char* ws = a.ws;
    const float* hmeta = (const float*)(ws + WS_HMETA); const float* ssq = (const float*)(ws + WS_SSQ); bf16_t* pb = (bf16_t*)(ws + WS_OB);
    const float* gm = a.in[5] + 1024;
    const bf16_t* hbp = (const bf16_t*)(ws + WS_HB);
    const int tid = threadIdx.x, cidx = tid & 255, half = tid >> 8, grp = cidx >> 6;
    const f32x4 gv = *(const f32x4*)(gm + 4 * cidx);
    LAS float* rs = (LAS float*)lds;
    for (int tile = blockIdx.x; tile < NREAL / 64; tile += G) {
        const int b = tile >> 7, t0 = (tile & 127) * 64, pos0 = NMETA + t0;
        __syncthreads();
        if (tid < 79) { const int pos = pos0 - 15 + tid; const int row = pos < NMETA ? MROW + pos : b * SEQ + pos - NMETA; rs[tid] = pos < NMETA ? mt::rstd_meta((const float*)(ws + WS_SSQM), pos) : pg8::row_rstd(ssq, row); }
        __syncthreads();
        const int start = pos0 + 32 * half;
        switch (grp) {
        case 0: pool_rows<2>(hbp, hmeta, pb, rs, gv, b, start, 32 * half, cidx); break;
        case 1: pool_rows<4>(hbp, hmeta, pb, rs, gv, b, start, 32 * half, cidx); break;
        case 2: pool_rows<8>(hbp, hmeta, pb, rs, gv, b, start, 32 * half, cidx); break;
        default: pool_rows<16>(hbp, hmeta, pb, rs, gv, b, start, 32 * half, cidx); break;
        }
    }
}

__device__ __forceinline__ void final_phase(const Args& a, int G) {
    const int tid = threadIdx.x, lane = tid & 63, wave = tid >> 6;
    const int gw = blockIdx.x * 8 + wave, NGW = G * 8;
    const float* gf = a.in[14]; const bf16_t* hb = (const bf16_t*)(a.ws + WS_HB);
    f32x4 gv[4];
#pragma unroll
    for (int j = 0; j < 4; ++j) gv[j] = ((const f32x4*)gf)[64 * j + lane];
    for (int row0 = gw; row0 < NREAL; row0 += 2 * NGW) {
        u32x2 wv[2][4];
#pragma unroll
        for (int q = 0; q < 2; ++q) { const int row = row0 + q * NGW < NREAL ? row0 + q * NGW : row0; const u32x2* hp = (const u32x2*)(hb + (size_t)row * DM);
#pragma unroll
            for (int j = 0; j < 4; ++j) wv[q][j] = hp[64 * j + lane]; }
#pragma unroll
        for (int q = 0; q < 2; ++q) { const int row = row0 + q * NGW; if (row >= NREAL) break;
            f32x4 v[4]; float s = 0.f;
#pragma unroll
            for (int j = 0; j < 4; ++j) { const u32x2 w = wv[q][j];
                v[j] = (f32x4){__builtin_bit_cast(float, w.x << 16), __builtin_bit_cast(float, w.x & 0xffff0000u), __builtin_bit_cast(float, w.y << 16), __builtin_bit_cast(float, w.y & 0xffff0000u)};
                s += (v[j][0] * v[j][0] + v[j][1] * v[j][1]) + (v[j][2] * v[j][2] + v[j][3] * v[j][3]); }
            s = wave_sum(s);
            const float rstd = 1.0f / sqrtf(s * (1.0f / 1024.0f) + EPS);
            f32x4* op = (f32x4*)(a.out + (size_t)row * DM);
#pragma unroll
            for (int j = 0; j < 4; ++j) op[64 * j + lane] = v[j] * rstd * gv[j];
        }
    }
}

#define XB_TMO      128
#define XB_XCNT(j)  (256  + 64 * (j))
#define XB_XSUB(j)  (1280 + 64 * (j))
#define XB_XGEN(j)  (2304 + 64 * (j))
#define XB_TOP      3328
#define XB_TOPGEN   3392
#define XCD_BAR_WORDS 3456
#define XB_SPIN_CAP (1u << 18)
__device__ __forceinline__ unsigned xb_ld(unsigned* p)              { return __hip_atomic_load(p, __ATOMIC_RELAXED, __HIP_MEMORY_SCOPE_AGENT); }
__device__ __forceinline__ unsigned xb_add(unsigned* p, unsigned v) { return __hip_atomic_fetch_add(p, v, __ATOMIC_RELAXED, __HIP_MEMORY_SCOPE_AGENT); }
__device__ __forceinline__ unsigned xb_xcc_id() { return (unsigned)__builtin_amdgcn_s_getreg((3 << 11) | 20) & 0xFu; }
#define XB_SPIN(cond, bar) do { unsigned _sp = 0; while (cond) { __builtin_amdgcn_s_sleep(0); \
    if ((++_sp & 255u) == 0u) { if (xb_ld(&(bar)[XB_TMO])) break; if (_sp > XB_SPIN_CAP) { atomicAdd(&(bar)[XB_TMO], 1u); break; } } } } while (0)
struct XcdBarrier { unsigned* bar; unsigned x; volatile LAS unsigned* st; };
__device__ __forceinline__ XcdBarrier xcd_barrier_post(unsigned* bar, volatile LAS unsigned* st) {
    XcdBarrier b; b.bar = bar; b.x = xb_xcc_id(); b.st = st;
    if (threadIdx.x == 0) (void)xb_add(&bar[XB_XCNT(b.x)], 1u);
    return b;
}
__device__ __forceinline__ void xcd_barrier_complete(unsigned* bar, unsigned x, unsigned& nloc, unsigned& nx) {
    const unsigned G = gridDim.x * gridDim.y * gridDim.z;
    unsigned sum, cnt, mine, sp = 0u;
    for (;;) {
        sum = 0u; cnt = 0u; mine = 0u;
#pragma unroll
        for (unsigned j = 0; j < 16; ++j) { const unsigned c = xb_ld(&bar[XB_XCNT(j)]); sum += c; cnt += (c > 0u) ? 1u : 0u; mine = (j == x) ? c : mine; }
        if (sum == G) break;
        __builtin_amdgcn_s_sleep(1);
        if ((++sp & 255u) == 0u) { if (xb_ld(&bar[XB_TMO])) break; if (sp > XB_SPIN_CAP) { atomicAdd(&bar[XB_TMO], 1u); break; } }
    }
    nloc = mine > 0u ? mine : 1u; nx = cnt > 0u ? cnt : 1u;
}
__device__ __forceinline__ void xcd_barrier(const XcdBarrier& b) {
    asm volatile("s_waitcnt vmcnt(0)" ::: "memory");
    __syncthreads();
    if (threadIdx.x == 0) {
        unsigned* bar = b.bar;
        __builtin_amdgcn_s_waitcnt(0);
        unsigned nloc = b.st[0], nx = b.st[1];
        if (nloc == 0u) { xcd_barrier_complete(bar, b.x, nloc, nx); b.st[0] = nloc; b.st[1] = nx; }
        const unsigned old = xb_add(&bar[XB_XSUB(b.x)], 1u);
        const unsigned gen = old / nloc;
        if (old + 1u == (gen + 1u) * nloc) {
            __builtin_amdgcn_fence(__ATOMIC_RELEASE, "agent");
            asm volatile("s_waitcnt vmcnt(0)" ::: "memory");
            const unsigned og = xb_add(&bar[XB_TOP], 1u);
            const unsigned tg = og / nx;
            if (og + 1u == (tg + 1u) * nx) xb_add(&bar[XB_TOPGEN], 1u);
            else XB_SPIN(xb_ld(&bar[XB_TOPGEN]) == tg, bar);
            __builtin_amdgcn_fence(__ATOMIC_ACQUIRE, "agent");
            xb_add(&bar[XB_XGEN(b.x)], 1u);
            asm volatile("s_waitcnt vmcnt(0)" ::: "memory");
        } else {
            XB_SPIN(xb_ld(&bar[XB_XGEN(b.x)]) == gen, bar);
            __builtin_amdgcn_fence(__ATOMIC_ACQUIRE, "agent");
            asm volatile("s_waitcnt vmcnt(0)" ::: "memory");
        }
    }
    __syncthreads();
}

constexpr int N_PHASES = 16;
#ifndef PHMASK
#define PHMASK 0xFFFF
#endif
#define PH_ON(k) ((PHMASK >> (k)) & 1)
__global__ void __launch_bounds__(512, 2) fwd_kernel(Args a) {
    extern __shared__ __attribute__((aligned(16))) unsigned char lds_raw[];
    LAS unsigned char* lds = (LAS unsigned char*)lds_raw;
    const int G = gridDim.x;
    unsigned char* ws = a.ws;
    bf16_t* hb = (bf16_t*)(ws + WS_HB); float* ssq = (float*)(ws + WS_SSQ); float* hmeta = (float*)(ws + WS_HMETA); bf16_t* ob = (bf16_t*)(ws + WS_OB);
    bf16_t* big = (bf16_t*)(ws + WS_BIG);
    const int lo = a.ph_lo, hi = a.ph_hi;
    volatile LAS unsigned* bst = (volatile LAS unsigned*)(lds + LDS_MISC);
    if (threadIdx.x < 2) bst[threadIdx.x] = 0u;
    __syncthreads();
    XcdBarrier xbar; xbar.bar = (unsigned*)(ws + WS_CTL + CTL_BAR); xbar.x = 0; xbar.st = bst;
    if (ONE_LAUNCH) xbar = xcd_barrier_post((unsigned*)(ws + WS_CTL + CTL_BAR), bst);
#define IN(k) (PH_ON(k) && lo <= (k) && (k) < hi)
#define SEAM(k) do { if (ONE_LAUNCH && lo <= (k) && (k) + 1 < hi) xcd_barrier(xbar); } while (0)
#define FFN_IN(k, mI, M_) do { if (IN(k)) { if ((M_) == MP) mt::ffn_in(lds, ws, (mI), G); pg8::Gemm g{hb, (const bf16_t*)(ws + WS_WIN + (mI) * WIN_BYTES), NREAL, 5632, 1024, 1024, 1024, 0}; pg8::StaticOrder S; S.init(NREAL, 5632, G, blockIdx.x); \
        pg8::EpiSwiGLU E{big, ssq}; pg8::gemm_phase(lds, g, S, E); } SEAM(k); } while (0)
#define FFN_OUT(k, mI, M_, WHB) do { if (IN(k)) { if ((M_) == MP) mt::resid<DFF>(lds, ws, big + (size_t)MROW * DFF, DFF, (const bf16_t*)(ws + WS_WOUT + (mI) * WOUT_BYTES), 0.5f, G); pg8::Gemm g{big, (const bf16_t*)(ws + WS_WOUT + (mI) * WOUT_BYTES), NREAL, 1024, DFF, DFF, DFF, 0}; pg8::StaticOrder S; S.init(NREAL, 1024, G, blockIdx.x); \
        pg8::EpiResid E{a.out, hb, ssq, nullptr, 0.5f, (WHB) ? 0 : 1}; pg8::gemm_phase(lds, g, S, E); } SEAM(k); } while (0)
    if (ONE_LAUNCH && lo < 0) cg::this_grid().sync();
    if (IN(0)) p0_prologue(a, lds, G);
    SEAM(0);
    FFN_IN(1, 0, MP);
    FFN_OUT(2, 0, MP, 1);
    if (IN(3)) {
        mt::attn_in(lds, ws, a.in[10], G);
        pg8::Gemm g{hb, (const bf16_t*)(ws + WS_WAI), NREAL, NATT, 1024, 1024, 1024, 0}; pg8::StaticOrder S; S.init(NREAL, NATT, G, blockIdx.x);
        pg8::EpiQKV E{big, (float*)(ws + WS_LOGF), ssq, a.in[10]}; pg8::gemm_phase(lds, g, S, E); }
    SEAM(3);
    if (IN(5)) attn_phase(a, lds, G);
    SEAM(5);
    if (IN(6)) {
        mt::resid<1024>(lds, ws, ob + (size_t)MROW * DM, DM, (const bf16_t*)(ws + WS_WAO), 1.0f, G);
        pg8::Gemm g{ob, (const bf16_t*)(ws + WS_WAO), NREAL, 1024, 1024, 1024, 1024, 0}; pg8::StaticOrder S; S.init(NREAL, 1024, G, blockIdx.x);
        pg8::EpiResid E{a.out, hb, ssq, nullptr, 1.0f, 0}; pg8::gemm_phase(lds, g, S, E); }
    SEAM(6);
    FFN_IN(7, 1, MP);
    FFN_OUT(8, 1, MP, 1);
    FFN_IN(9, 2, MP);
    FFN_OUT(10, 2, MP, 1);
    if (IN(11)) pool_phase(a, lds, G);
    SEAM(11);
    if (IN(12)) {
        pg8::Gemm g{ob, (const bf16_t*)(ws + WS_WPOOL), NREAL, 1024, 256, 1024, 256, 256}; pg8::StaticOrder S; S.init(NREAL, 1024, G, blockIdx.x);
        pg8::EpiResid E{a.out, hb, ssq, a.in[13], 1.0f, 0}; pg8::gemm_phase(lds, g, S, E); }
    SEAM(12);
    FFN_IN(13, 3, NREAL);
    FFN_OUT(14, 3, NREAL, 1);
    if (IN(15)) final_phase(a, G);
#undef IN
#undef SEAM
}

extern "C" void kernel_launch(void* const* d_in, const int* in_sizes, int n_in, void* d_out, int out_size, void* d_ws, size_t ws_size, hipStream_t stream) {
    static int grid = 0;
    if (grid == 0) {
        if (n_in != 15 || out_size != NREAL * DM || ws_size < WS_END) { fprintf(stderr, "kernel_launch: unexpected shapes (n_in %d out %d ws %zu need %zu)\n", n_in, out_size, ws_size, (size_t)WS_END); grid = -1; return; }
        int dev = 0, cus = 0;
        if (hipGetDevice(&dev) != hipSuccess || hipDeviceGetAttribute(&cus, hipDeviceAttributeMultiprocessorCount, dev) != hipSuccess) { grid = -1; return; }
        if (hipFuncSetAttribute((const void*)fwd_kernel, hipFuncAttributeMaxDynamicSharedMemorySize, LDS_BYTES) != hipSuccess) { fprintf(stderr, "kernel_launch: hipFuncSetAttribute failed\n"); grid = -1; return; }
        int per_cu = 0;
        if (hipOccupancyMaxActiveBlocksPerMultiprocessor(&per_cu, (const void*)fwd_kernel, 512, LDS_BYTES) != hipSuccess || per_cu < 1) { fprintf(stderr, "kernel_launch: occupancy query says %d\n", per_cu); }
        (void)hipGetLastError();
        grid = cus;
    }
    if (grid < 0) return;
    (void)hipMemsetAsync((char*)d_ws + WS_CTL, 0, CTL_ZERO, stream);
    Args a{};
    for (int i = 0; i < 15; ++i) a.in[i] = (const float*)d_in[i];
    a.out = (float*)d_out; a.ws = (unsigned char*)d_ws;
#if ONE_LAUNCH
    a.ph_lo = 0; a.ph_hi = N_PHASES;
    void* args[] = {&a};
    hipError_t e = hipLaunchCooperativeKernel((const void*)fwd_kernel, dim3(grid), dim3(512), args, LDS_BYTES, stream);
    if (e != hipSuccess) fprintf(stderr, "cooperative launch failed: %s (grid %d)\n", hipGetErrorString(e), grid);
#else
    for (int ph = 0; ph < N_PHASES; ++ph) { a.ph_lo = ph; a.ph_hi = ph + 1; hipLaunchKernelGGL(fwd_kernel, dim3(grid), dim3(512), LDS_BYTES, stream, a); }
#endif
}
```
